# Optimizing an MI355X kernel written in HIP

```python
import math
import jax, jax.numpy as jnp
from jax import lax
import numpy as np

D_MODEL = 1024
BATCH = 8
SEQ = 4096
DEPTH = 4

A_HEADS = 4
A_QK_DIM = 64
A_V_DIM = 2 * A_QK_DIM
A_WIDTH = A_HEADS * A_V_DIM
B_PAIRS = ((128, 1), (512, 4), (2048, 16))
B_GROUPS = len(B_PAIRS)
B_HEADS = 4
B_HEAD_DIM = 128
B_WIDTH = B_HEADS * B_HEAD_DIM
B_BLOCK = 128
Q_BLOCK = 128
A_Q_COLS = A_HEADS * 2 * A_QK_DIM
A_K_COLS = A_HEADS * 2 * A_QK_DIM
A_V_COLS = A_HEADS * A_V_DIM
B_COLS = B_GROUPS * B_WIDTH
GATE_COLS = 2 * D_MODEL
IN_COLS = A_Q_COLS + A_K_COLS + A_V_COLS + 3 * B_COLS + GATE_COLS
D_FF = 2816
CONV_WIDTH = 3
ROPE_THETA = 10000.0
NORM_EPS = 1e-6

kernel_name = "hybrid_diffattn_dilated_convglu"


def rms_norm(x, g):
    xf = x.astype(jnp.float32)
    y = xf * lax.rsqrt(jnp.mean(xf * xf, axis=-1, keepdims=True) + NORM_EPS)
    return (y * g.astype(jnp.float32)).astype(x.dtype)


def rope_tables(positions, dim):
    inv = ROPE_THETA ** (-jnp.arange(0, dim, 2, dtype=jnp.float32) / dim)
    ang = positions.astype(jnp.float32)[..., None] * inv
    return jnp.cos(ang)[:, :, None, None, :], jnp.sin(ang)[:, :, None, None, :]


def apply_rope(t, cos, sin):
    tf = t.astype(jnp.float32)
    t1, t2 = jnp.split(tf, 2, axis=-1)
    return jnp.concatenate([t1 * cos - t2 * sin, t2 * cos + t1 * sin], axis=-1).astype(t.dtype)


def diff_attention(q, k, v, lam):
    b, s, h, _, dqk = q.shape
    nq = s // Q_BLOCK
    scale = dqk ** -0.5
    qb = q.reshape(b, nq, Q_BLOCK, h, 2, dqk).transpose(1, 0, 2, 3, 4, 5)
    kpos = jnp.arange(s)

    def one_block(args):
        qi, i = args
        sc = jnp.einsum('bqhcd,bkhcd->bchqk', qi, k).astype(jnp.float32) * scale
        qpos = i * Q_BLOCK + jnp.arange(Q_BLOCK)
        causal = kpos[None, :] <= qpos[:, None]
        p = jax.nn.softmax(jnp.where(causal, sc, -jnp.inf), axis=-1)
        a = p[:, 0] - lam * p[:, 1]
        return jnp.einsum('bhqk,bkhd->bqhd', a.astype(v.dtype), v)

    o = lax.map(one_block, (qb, jnp.arange(nq)))
    return o.transpose(1, 0, 2, 3, 4).reshape(b, s, h, v.shape[-1])


def dilated_group(q, k, v, window, dil):
    b, s, h, d = q.shape
    L = s // dil
    nwin = window // dil
    nb = -(-L // B_BLOCK)
    Lp = nb * B_BLOCK

    def to_blocks(t):
        t = t.reshape(b, L, dil, h, d).transpose(0, 2, 1, 3, 4)
        t = jnp.pad(t, ((0, 0), (0, 0), (0, Lp - L), (0, 0), (0, 0)))
        return t.reshape(b, dil, nb, B_BLOCK, h, d)

    def with_prev(t):
        prev = jnp.pad(t[:, :, :-1], ((0, 0), (0, 0), (1, 0), (0, 0), (0, 0), (0, 0)))
        return jnp.concatenate([prev, t], axis=3)

    qb, kb, vb = to_blocks(q), to_blocks(k), to_blocks(v)
    kk, vv = with_prev(kb), with_prev(vb)
    sc = jnp.einsum('brnqhd,brnkhd->brnhqk', qb, kk).astype(jnp.float32) * (d ** -0.5)
    qi = jnp.arange(B_BLOCK)[:, None]
    kj = jnp.arange(2 * B_BLOCK)[None, :]
    rel = qi - kj + B_BLOCK
    kabs = jnp.arange(nb)[:, None, None] * B_BLOCK + kj - B_BLOCK
    valid = (rel >= 0) & (rel <= nwin) & (kabs >= 0)
    sc = jnp.where(valid[None, None, :, None], sc, -jnp.inf)
    m = jnp.max(sc, axis=-1, keepdims=True)
    p = jnp.exp(sc - m)
    den = jnp.sum(p, axis=-1, keepdims=True)
    o = jnp.einsum('brnhqk,brnkhd->brnqhd', (p / den).astype(v.dtype), vv)
    lse = (m + jnp.log(den))[..., 0].transpose(0, 1, 2, 4, 3)

    def from_blocks(t):
        t = t.reshape((b, dil, Lp) + t.shape[4:])[:, :, :L]
        t = jnp.moveaxis(t, 1, 2)
        return t.reshape((b, s) + t.shape[3:])

    return from_blocks(o), from_blocks(lse)


def causal_depthwise_conv(u, w, bias):
    s = u.shape[1]
    up = jnp.pad(u, ((0, 0), (CONV_WIDTH - 1, 0), (0, 0)))
    out = sum(up[:, j:j + s] * w[j] for j in range(CONV_WIDTH))
    return out + bias


def setup_inputs(seed: int = 0) -> dict:
    key = jax.random.key(seed)
    ks = jax.random.split(key, 20)
    f32 = jnp.float32

    def nrm(k, shape, scale):
        return jax.random.normal(k, shape, f32) * scale

    def gain(k, shape):
        return 1.0 + 0.05 * jax.random.normal(k, shape, f32)

    x = jax.random.normal(ks[0], (BATCH, SEQ, D_MODEL), f32)
    offset = jax.random.randint(ks[1], (BATCH, 1), 0, 1024, dtype=jnp.int32)
    positions = (offset + jnp.arange(SEQ, dtype=jnp.int32)[None, :]).astype(jnp.int32)
    return {
        "x": x,
        "positions": positions,
        "pre_mix_g": gain(ks[2], (DEPTH, D_MODEL)),
        "w_in": nrm(ks[3], (DEPTH, D_MODEL, IN_COLS), D_MODEL ** -0.5),
        "diff_lambda": nrm(ks[4], (DEPTH, 4, A_QK_DIM), 0.1),
        "diff_head_g": gain(ks[5], (DEPTH, A_V_DIM)),
        "w_a_out": nrm(ks[6], (DEPTH, A_WIDTH, D_MODEL), A_WIDTH ** -0.5),
        "w_b_out": nrm(ks[7], (DEPTH, B_WIDTH, D_MODEL), B_WIDTH ** -0.5),
        "w_mix_out": nrm(ks[8], (DEPTH, D_MODEL, D_MODEL), D_MODEL ** -0.5),
        "post_mix_g": gain(ks[9], (DEPTH, D_MODEL)),
        "pre_ffn_g": gain(ks[10], (DEPTH, D_MODEL)),
        "w_up": nrm(ks[11], (DEPTH, D_MODEL, 2 * D_FF), D_MODEL ** -0.5),
        "conv_w": nrm(ks[12], (DEPTH, CONV_WIDTH, 2 * D_FF), CONV_WIDTH ** -0.5),
        "conv_b": nrm(ks[13], (DEPTH, 2 * D_FF), 0.01),
        "w_down": nrm(ks[14], (DEPTH, D_FF, D_MODEL), D_FF ** -0.5),
        "post_ffn_g": gain(ks[15], (DEPTH, D_MODEL)),
    }


def reference(x, positions, pre_mix_g, w_in, diff_lambda, diff_head_g, w_a_out, w_b_out,
              w_mix_out, post_mix_g, pre_ffn_g, w_up, conv_w, conv_b, w_down, post_ffn_g):
    b, s, _ = x.shape
    cos_a, sin_a = rope_tables(positions, A_QK_DIM)
    cos_b, sin_b = rope_tables(positions, B_HEAD_DIM)
    split_at = np.cumsum([A_Q_COLS, A_K_COLS, A_V_COLS, B_COLS, B_COLS, B_COLS]).tolist()

    for l in range(DEPTH):
        h = rms_norm(x, pre_mix_g[l])
        proj = h @ w_in[l]
        qa, ka, va, qb, kb, vb, gates = jnp.split(proj, split_at, axis=-1)

        qa = apply_rope(qa.reshape(b, s, A_HEADS, 2, A_QK_DIM), cos_a, sin_a)
        ka = apply_rope(ka.reshape(b, s, A_HEADS, 2, A_QK_DIM), cos_a, sin_a)
        va = va.reshape(b, s, A_HEADS, A_V_DIM)
        lam_init = 0.8 - 0.6 * math.exp(-0.3 * l)
        lv = diff_lambda[l].astype(jnp.float32)
        lam = jnp.exp(jnp.sum(lv[0] * lv[1])) - jnp.exp(jnp.sum(lv[2] * lv[3])) + lam_init
        oa = diff_attention(qa, ka, va, lam)
        oa = rms_norm(oa, diff_head_g[l]) * (1.0 - lam_init)
        ya = oa.reshape(b, s, A_WIDTH) @ w_a_out[l]

        qb = apply_rope(qb.reshape(b, s, B_GROUPS, B_HEADS, B_HEAD_DIM), cos_b, sin_b)
        kb = apply_rope(kb.reshape(b, s, B_GROUPS, B_HEADS, B_HEAD_DIM), cos_b, sin_b)
        vb = vb.reshape(b, s, B_GROUPS, B_HEADS, B_HEAD_DIM)
        outs, lses = [], []
        for g, (window, dil) in enumerate(B_PAIRS):
            o_g, lse_g = dilated_group(qb[:, :, g], kb[:, :, g], vb[:, :, g], window, dil)
            outs.append(o_g)
            lses.append(lse_g)
        wts = jax.nn.softmax(jnp.stack(lses, axis=0), axis=0)
        ob = jnp.einsum('gbsh,gbshd->bshd', wts.astype(x.dtype), jnp.stack(outs, axis=0))
        yb = ob.reshape(b, s, B_WIDTH) @ w_b_out[l]

        g_a, g_b = jnp.split(jax.nn.sigmoid(gates), 2, axis=-1)
        mix = (g_a * ya + g_b * yb) @ w_mix_out[l]
        x = x + rms_norm(mix, post_mix_g[l])

        h = rms_norm(x, pre_ffn_g[l])
        u = causal_depthwise_conv(h @ w_up[l], conv_w[l], conv_b[l])
        gate, val = jnp.split(u, 2, axis=-1)
        y = (jax.nn.gelu(gate, approximate=True) * val) @ w_down[l]
        x = x + rms_norm(y, post_ffn_g[l])
    return x
```

```cpp
#include <hip/hip_runtime.h>
#include <hip/hip_cooperative_groups.h>
#include <cstdio>
#include <cstdint>
namespace cg = cooperative_groups;

#ifndef MK_SINGLE
#define MK_SINGLE 1
#endif

#ifndef MK_ONLY
#define MK_ONLY -1
#endif
#define PH_EN(k) ((MK_ONLY) < 0 || (MK_ONLY) == (k))
#define LAS __attribute__((address_space(3)))
typedef unsigned short bf16_t;
typedef short bf16x8 __attribute__((ext_vector_type(8)));
typedef short s16x4 __attribute__((ext_vector_type(4)));
typedef float f32x4 __attribute__((ext_vector_type(4)));
typedef float f32x2 __attribute__((ext_vector_type(2)));
typedef unsigned u32x4 __attribute__((ext_vector_type(4)));
typedef unsigned u32x2 __attribute__((ext_vector_type(2)));
typedef __bf16 bf2_t __attribute__((ext_vector_type(2)));

constexpr int DM = 1024, NBATCH = 8, SEQ = 4096, DEPTH = 4, NTOK = NBATCH * SEQ, INC = 8192, DFF = 2816, UPC = 2 * DFF;
constexpr float EPS = 1e-6f;
constexpr float LOG2E = 1.4426950408889634f;
constexpr int NPH = 11;
constexpr int LDS_BYTES = 131072;

constexpr size_t W_IN = 0, W_A = W_IN + (size_t)INC * DM * 2, W_B = W_A + (size_t)DM * 512 * 2, W_MIX = W_B + (size_t)DM * 512 * 2,
                 W_UP = W_MIX + (size_t)DM * DM * 2, W_DOWN = W_UP + (size_t)UPC * DM * 2, W_END = W_DOWN + (size_t)DM * DFF * 2;
constexpr size_t WS_HB = (W_END + 255) & ~(size_t)255;
constexpr size_t WS_CH = WS_HB + (size_t)NTOK * DM * 2;
constexpr size_t PER_TOK = 16896 + 2048 + 5120 + 48;

struct Params {
    const float* x_in; const int* pos; const float* pre_mix_g; const float* w_in; const float* diff_lambda; const float* diff_head_g;
    const float* w_a_out; const float* w_b_out; const float* w_mix_out; const float* post_mix_g; const float* pre_ffn_g;
    const float* w_up; const float* conv_w; const float* conv_b; const float* w_down; const float* post_ffn_g;
    float* out; unsigned char* ws;
    int Mc, nchunk, ph_lo, ph_hi;
};

__device__ __forceinline__ unsigned pack2(float a, float b) { f32x2 v = {a, b}; bf2_t r = __builtin_convertvector(v, bf2_t); return __builtin_bit_cast(unsigned, r); }
__device__ __forceinline__ float bflo(unsigned u) { return __uint_as_float(u << 16); }
__device__ __forceinline__ float bfhi(unsigned u) { return __uint_as_float(u & 0xffff0000u); }
__device__ __forceinline__ int opaque_tid() { int t = threadIdx.x; asm volatile("" : "+v"(t)); return t; }
__device__ __forceinline__ int opaque_bid() { int t = blockIdx.x; asm volatile("" : "+s"(t)); return t; }
__device__ __forceinline__ float wave_sum(float v) {
#pragma unroll
    for (int o = 32; o > 0; o >>= 1) v += __shfl_xor(v, o);
    return v;
}

namespace pg8 {
constexpr int BM = 256, BK = 64, HALF = 128, HTB = HALF * BK * 2, STAGE_BYTES = 8 * HTB, NXCD = 8, WGM = 8;
__device__ __forceinline__ int lds_byte(int r, int c) { const int st = (r >> 4) * 2 + (c >> 5), rr = r & 15, cc = c & 31, ob = rr * 64 + cc * 2; return st * 1024 + (ob ^ (((ob >> 9) & 1) << 5)); }
__device__ __forceinline__ void stage_rc(int b, int& R, int& C) { const int st = b / 1024, sb = b % 1024, swz = sb ^ (((sb >> 9) & 1) << 5); R = (st >> 1) * 16 + swz / 64; C = (st & 1) * 32 + (swz % 64) / 2; }
__device__ __forceinline__ int perm32(int rho) { const int n = rho >> 4, i = rho & 15; return 8 * (i >> 2) + 4 * n + (i & 3); }

struct Unit { int pm, pn; };
struct Gemm { const bf16_t* A; const bf16_t* Bt; int M, N, K, lda; };

struct StaticOrder {
    int nM, nN, nwg, G, c;
    __device__ void init(int M, int N, int G_, int c_) { nM = M / BM; nN = N / BM; nwg = nM * nN; G = G_; c = c_; }
    __device__ bool next(int i, Unit& u) const {
        const long L = (long)i * G + c; if (L >= nwg) return false;
        int wgid = (int)L; { const int q = nwg / NXCD, r = nwg % NXCD, xcd = wgid % NXCD, off = wgid / NXCD; wgid = (xcd < r ? xcd * (q + 1) : r * (q + 1) + (xcd - r) * q) + off; }
        const int nig = WGM * nN, gid = wgid / nig, fm = gid * WGM, gsz = (nM - fm) < WGM ? (nM - fm) : WGM;
        u.pm = fm + ((wgid % nig) % gsz); u.pn = (wgid % nig) / gsz; return true;
    }
};

template <class Epi>
__device__ __forceinline__ void gemm_phase(LAS unsigned char* lds, const Gemm g, const StaticOrder& S, const Epi& E) {
    const int tid = opaque_tid(), wid = __builtin_amdgcn_readfirstlane(tid >> 6), lane = tid & 63, wr = wid >> 2, wc = wid & 3, fr = lane & 15, fq = lane >> 4;
    const int K = g.K, nt = K / BK, lda = g.lda;
    unsigned voffA[2], voffB[2];
#pragma unroll
    for (int i = 0; i < 2; ++i) { int R, C; stage_rc(tid * 16 + i * 8192, R, C); const int Rb = Epi::PERM ? ((R & ~31) + perm32(R & 31)) : R;
        voffA[i] = (unsigned)(R * lda + C) * 2u; voffB[i] = (unsigned)(Rb * K + C) * 2u; }
    const size_t kstep = (size_t)(BK * 2);
    const size_t hstepA = (size_t)HALF * lda * 2, hstepB = (size_t)HALF * K * 2;
    const size_t tstepA = 2 * hstepA, tstepB = 2 * hstepB;
    const unsigned ldsw = (unsigned)wid * 1024u;
    const int aoff = lds_byte(wr * 64 + fr, fq * 8), boff = lds_byte(wc * 32 + fr, fq * 8);
#define PG8_SA(b, h) (((b) * 2 + (h)) * HTB)
#define PG8_SB(b, h) ((4 + (b) * 2 + (h)) * HTB)
#define PG8_STAGE(bufoff, gbase, voff) do { _Pragma("unroll") for (int _i = 0; _i < 2; ++_i) \
        __builtin_amdgcn_global_load_lds((const unsigned*)((const char*)(gbase) + (voff)[_i]), (LAS unsigned*)(lds + (bufoff) + ldsw + _i * 8192), 16, 0, 0); } while (0)
#define PG8_LDA(dst, b, h) do { _Pragma("unroll") for (int m = 0; m < 4; ++m) _Pragma("unroll") for (int k = 0; k < 2; ++k) dst[m][k] = *(const LAS bf16x8*)(lds + PG8_SA(b, h) + aoff + m * 2048 + k * 1024); } while (0)
#define PG8_LDB(dst, b, h) do { _Pragma("unroll") for (int n = 0; n < 2; ++n) _Pragma("unroll") for (int k = 0; k < 2; ++k) dst[n][k] = *(const LAS bf16x8*)(lds + PG8_SB(b, h) + boff + n * 2048 + k * 1024); } while (0)
#define PG8_MMA(ai, bj, At, Bt) do { __builtin_amdgcn_s_setprio(1); _Pragma("unroll") for (int m = 0; m < 4; ++m) _Pragma("unroll") for (int n = 0; n < 2; ++n) _Pragma("unroll") for (int k = 0; k < 2; ++k) \
        acc[ai][bj][m][n] = __builtin_amdgcn_mfma_f32_16x16x32_bf16(Bt[n][k], At[m][k], acc[ai][bj][m][n], 0, 0, 0); __builtin_amdgcn_s_setprio(0); } while (0)
#define PG8_WAIT_V(n) asm volatile("s_waitcnt vmcnt(" #n ")" ::: "memory")
#define PG8_WAIT_L(n) asm volatile("s_waitcnt lgkmcnt(" #n ")" ::: "memory")
#define PG8_BAR __builtin_amdgcn_s_barrier()
#define PG8_SCHED __builtin_amdgcn_sched_barrier(0)
    Unit cur, nxt; int ui = 0;
    if (!S.next(0, cur)) return;
    f32x4 acc[2][2][4][2];
#pragma unroll
    for (int a = 0; a < 2; ++a)
#pragma unroll
        for (int b = 0; b < 2; ++b)
#pragma unroll
            for (int m = 0; m < 4; ++m)
#pragma unroll
                for (int n = 0; n < 2; ++n) acc[a][b][m][n] = (f32x4){0.f, 0.f, 0.f, 0.f};
    bf16x8 At[4][2], B0[2][2], B1[2][2];
    const char* cA = (const char*)g.A + (size_t)cur.pm * tstepA; const char* cB = (const char*)g.Bt + (size_t)cur.pn * tstepB;
    PG8_STAGE(PG8_SB(0, 0), cB, voffB); PG8_STAGE(PG8_SA(0, 0), cA, voffA); PG8_STAGE(PG8_SB(0, 1), cB + hstepB, voffB); PG8_STAGE(PG8_SA(0, 1), cA + hstepA, voffA);
    if (wr == 1) PG8_BAR;
    PG8_WAIT_V(4); PG8_BAR;
    PG8_STAGE(PG8_SB(1, 0), cB + kstep, voffB); PG8_STAGE(PG8_SA(1, 0), cA + kstep, voffA); PG8_STAGE(PG8_SB(1, 1), cB + hstepB + kstep, voffB);
    PG8_WAIT_V(6); PG8_BAR;
    for (;;) {
        const bool has_next = S.next(ui + 1, nxt);
        const char* nA = has_next ? (const char*)g.A + (size_t)nxt.pm * tstepA : cA; const char* nB = has_next ? (const char*)g.Bt + (size_t)nxt.pn * tstepB : cB;
        for (int t = 0; t < nt; t += 2) {
            const bool last = (t == nt - 2);
            const char* a1 = cA + (size_t)(t + 1) * kstep;
            const char* a2 = last ? nA : cA + (size_t)(t + 2) * kstep; const char* b2 = last ? nB : cB + (size_t)(t + 2) * kstep;
            const char* a3 = a2 + kstep; const char* b3 = b2 + kstep;
            PG8_LDB(B0, 0, 0); PG8_SCHED; PG8_LDA(At, 0, 0); PG8_STAGE(PG8_SA(1, 1), a1 + hstepA, voffA);
            PG8_WAIT_L(8); PG8_BAR; PG8_WAIT_L(0); PG8_MMA(0, 0, At, B0); PG8_BAR; PG8_SCHED;
            PG8_LDB(B1, 0, 1); PG8_STAGE(PG8_SB(0, 0), b2, voffB);
            PG8_BAR; PG8_WAIT_L(0); PG8_MMA(0, 1, At, B1); PG8_BAR;
            PG8_LDA(At, 0, 1); PG8_STAGE(PG8_SA(0, 0), a2, voffA);
            PG8_BAR; PG8_WAIT_L(0); PG8_MMA(1, 0, At, B0); PG8_BAR; PG8_SCHED;
            PG8_STAGE(PG8_SB(0, 1), b2 + hstepB, voffB);
            PG8_WAIT_V(6); PG8_BAR; PG8_MMA(1, 1, At, B1); PG8_BAR;
            PG8_LDB(B0, 1, 0); PG8_SCHED; PG8_LDA(At, 1, 0); PG8_STAGE(PG8_SA(0, 1), a2 + hstepA, voffA);
            PG8_WAIT_L(8); PG8_BAR; PG8_WAIT_L(0); PG8_MMA(0, 0, At, B0); PG8_BAR; PG8_SCHED;
            PG8_LDB(B1, 1, 1); PG8_STAGE(PG8_SB(1, 0), b3, voffB);
            PG8_BAR; PG8_WAIT_L(0); PG8_MMA(0, 1, At, B1); PG8_BAR;
            PG8_LDA(At, 1, 1); PG8_STAGE(PG8_SA(1, 0), a3, voffA);
            PG8_BAR; PG8_WAIT_L(0); PG8_MMA(1, 0, At, B0); PG8_BAR; PG8_SCHED;
            PG8_STAGE(PG8_SB(1, 1), b3 + hstepB, voffB);
            PG8_WAIT_V(6); PG8_BAR; PG8_MMA(1, 1, At, B1); PG8_BAR;
        }
        E(acc, cur, wr, wc, fr, fq);
        if (!has_next) break;
#pragma unroll
        for (int a = 0; a < 2; ++a)
#pragma unroll
            for (int b = 0; b < 2; ++b)
#pragma unroll
                for (int m = 0; m < 4; ++m)
#pragma unroll
                    for (int n = 0; n < 2; ++n) acc[a][b][m][n] = (f32x4){0.f, 0.f, 0.f, 0.f};
        cur = nxt; cA = nA; cB = nB; ++ui;
    }
    PG8_WAIT_V(0);
    if (wr == 0) PG8_BAR;
    PG8_BAR;
#undef PG8_SA
#undef PG8_SB
#undef PG8_STAGE
#undef PG8_LDA
#undef PG8_LDB
#undef PG8_MMA
#undef PG8_WAIT_V
#undef PG8_WAIT_L
#undef PG8_BAR
#undef PG8_SCHED
}

struct EpiProj {
    static constexpr bool PERM = true;
    bf16_t* O; const int* pos;
    __device__ __forceinline__ void operator()(const f32x4 (&acc)[2][2][4][2], const Unit& u, int wr, int wc, int fr, int fq) const {
        const int pn = u.pn;
        int type;
        if (pn < 4) type = 1; else if (pn < 6) type = 0; else if (pn < 18) type = 2; else if (pn < 24) type = 0; else type = 3;
        float inv[2][4];
#pragma unroll
        for (int bj = 0; bj < 2; ++bj)
#pragma unroll
            for (int i = 0; i < 4; ++i) inv[bj][i] = 0.f;
        if (type == 1 || type == 2) {
            const int dim = type == 1 ? 64 : 128;
            const float c1 = (type == 1 ? (2.f / 64.f) : (2.f / 128.f)) * 13.287712379549449f;
#pragma unroll
            for (int bj = 0; bj < 2; ++bj) {
                const int col = pn * 256 + bj * 128 + wc * 32 + 8 * fq; const int jf0 = (col & (dim - 1)) >> 1;
#pragma unroll
                for (int i = 0; i < 4; ++i) inv[bj][i] = __builtin_amdgcn_exp2f(-(float)(jf0 + i) * c1 - 2.651496129472319f);
            }
        }
#pragma unroll
        for (int ai = 0; ai < 2; ++ai)
#pragma unroll
            for (int m = 0; m < 4; ++m) {
                const int row = u.pm * 256 + ai * 128 + wr * 64 + m * 16 + fr;
                const float posf = (float)pos[row];
#pragma unroll
                for (int bj = 0; bj < 2; ++bj) {
                    const int col = pn * 256 + bj * 128 + wc * 32 + 8 * fq;
                    f32x4 v0 = acc[ai][bj][m][0], v1 = acc[ai][bj][m][1];
                    float v[8] = {v0[0], v0[1], v0[2], v0[3], v1[0], v1[1], v1[2], v1[3]};
                    if (type == 1 || type == 2) {
#pragma unroll
                        for (int i = 0; i < 4; ++i) {
                            float rev = posf * inv[bj][i]; rev -= __builtin_rintf(rev);
                            const float sn = __builtin_amdgcn_sinf(rev), cs = __builtin_amdgcn_cosf(rev);
                            const float x1 = v[2 * i], x2 = v[2 * i + 1];
                            v[2 * i] = x1 * cs - x2 * sn; v[2 * i + 1] = x2 * cs + x1 * sn;
                        }
                    } else if (type == 3) {
#pragma unroll
                        for (int i = 0; i < 8; ++i) v[i] = __builtin_amdgcn_rcpf(1.f + __builtin_amdgcn_exp2f(-v[i] * LOG2E));
                    }
                    u32x4 o = {pack2(v[0], v[1]), pack2(v[2], v[3]), pack2(v[4], v[5]), pack2(v[6], v[7])};
                    *(u32x4*)(O + (size_t)row * INC + col) = o;
                }
            }
    }
};
struct EpiBf16 {
    static constexpr bool PERM = true;
    bf16_t* O; int ldc;
    __device__ __forceinline__ void operator()(const f32x4 (&acc)[2][2][4][2], const Unit& u, int wr, int wc, int fr, int fq) const {
#pragma unroll
        for (int ai = 0; ai < 2; ++ai)
#pragma unroll
            for (int m = 0; m < 4; ++m) {
                const int row = u.pm * 256 + ai * 128 + wr * 64 + m * 16 + fr;
#pragma unroll
                for (int bj = 0; bj < 2; ++bj) {
                    const int col = u.pn * 256 + bj * 128 + wc * 32 + 8 * fq;
                    f32x4 v0 = acc[ai][bj][m][0], v1 = acc[ai][bj][m][1];
                    u32x4 o = {pack2(v0[0], v0[1]), pack2(v0[2], v0[3]), pack2(v1[0], v1[1]), pack2(v1[2], v1[3])};
                    *(u32x4*)(O + (size_t)row * ldc + col) = o;
                }
            }
    }
};
template <int MODE> struct EpiGate {
    static constexpr bool PERM = true;
    bf16_t* Z; const bf16_t* P; int goff;
    __device__ __forceinline__ void operator()(const f32x4 (&acc)[2][2][4][2], const Unit& u, int wr, int wc, int fr, int fq) const {
#pragma unroll
        for (int ai = 0; ai < 2; ++ai)
#pragma unroll
            for (int m = 0; m < 4; ++m) {
                const int row = u.pm * 256 + ai * 128 + wr * 64 + m * 16 + fr;
#pragma unroll
                for (int bj = 0; bj < 2; ++bj) {
                    const int col = u.pn * 256 + bj * 128 + wc * 32 + 8 * fq;
                    f32x4 v0 = acc[ai][bj][m][0], v1 = acc[ai][bj][m][1];
                    const u32x4 gt = *(const u32x4*)(P + (size_t)row * INC + goff + col);
                    float r[8] = {v0[0] * bflo(gt[0]), v0[1] * bfhi(gt[0]), v0[2] * bflo(gt[1]), v0[3] * bfhi(gt[1]),
                                  v1[0] * bflo(gt[2]), v1[1] * bfhi(gt[2]), v1[2] * bflo(gt[3]), v1[3] * bfhi(gt[3])};
                    u32x4* zp = (u32x4*)(Z + (size_t)row * DM + col);
                    if (MODE == 1) { const u32x4 zo = *zp;
                        r[0] += bflo(zo[0]); r[1] += bfhi(zo[0]); r[2] += bflo(zo[1]); r[3] += bfhi(zo[1]);
                        r[4] += bflo(zo[2]); r[5] += bfhi(zo[2]); r[6] += bflo(zo[3]); r[7] += bfhi(zo[3]); }
                    u32x4 o = {pack2(r[0], r[1]), pack2(r[2], r[3]), pack2(r[4], r[5]), pack2(r[6], r[7])};
                    *zp = o;
                }
            }
    }
};
struct EpiF32 {
    static constexpr bool PERM = false;
    float* C; int ldc;
    __device__ __forceinline__ void operator()(const f32x4 (&acc)[2][2][4][2], const Unit& u, int wr, int wc, int fr, int fq) const {
#pragma unroll
        for (int ai = 0; ai < 2; ++ai)
#pragma unroll
            for (int m = 0; m < 4; ++m) {
                float* rowp = C + (size_t)(u.pm * 256 + ai * 128 + wr * 64 + m * 16 + fr) * ldc + u.pn * 256 + wc * 32 + 4 * fq;
#pragma unroll
                for (int bj = 0; bj < 2; ++bj)
#pragma unroll
                    for (int n = 0; n < 2; ++n) *(f32x4*)(rowp + bj * 128 + n * 16) = acc[ai][bj][m][n];
            }
    }
};
}

__device__ __forceinline__ void convert_matrix(const float* __restrict__ src, bf16_t* __restrict__ dst, int K, int N, int kind, const float* __restrict__ rowg, float rowmul,
                                               int tile0, int ntiles_total_before, int& item, int stride, LAS float* tile) {
    const int nTk = K / 64, nT = (N / 64) * nTk;
    const int tid = opaque_tid();
    while (item < ntiles_total_before + nT) {
        const int t = item - ntiles_total_before; const int tn = t / nTk, tk = t % nTk;
        {
            const int nl = tid & 63, kl0 = tid >> 6; const int ns = tn * 64 + nl;
            int no = ns; float cs = 1.f;
            if (kind == 0) {
                if (ns < 1024) { const int pp = ns & 63; no = (ns & ~63) + (pp & 1) * 32 + (pp >> 1); if (ns < 512) cs = 0.125f * LOG2E; }
                else if (ns >= 1536 && ns < 4608) { const int pp = ns & 127; no = (ns & ~127) + (pp & 1) * 64 + (pp >> 1); if (ns < 3072) cs = 0.08838834764831845f * LOG2E; }
            } else if (kind == 4) { no = (ns & 1) ? DFF + (ns >> 1) : (ns >> 1); }
#pragma unroll
            for (int i = 0; i < 8; ++i) { const int kl = kl0 + 8 * i, k = tk * 64 + kl;
                float v = src[(size_t)k * N + no] * cs;
                if (rowg) v *= rowg[(kind == 1) ? (k & 127) : k] * rowmul;
                tile[kl * 65 + nl] = v; }
        }
        __syncthreads();
        {
            const int kl = tid & 63, nl0 = tid >> 6;
#pragma unroll
            for (int i = 0; i < 8; ++i) { const int nl = nl0 + 8 * i;
                const unsigned pk = pack2(tile[kl * 65 + nl], 0.f);
                dst[(size_t)(tn * 64 + nl) * K + tk * 64 + kl] = (bf16_t)(pk & 0xffffu); }
        }
        __syncthreads();
        item += stride;
    }
    (void)tile0;
}

__device__ void convert_weights(const Params& p, int l, LAS unsigned char* lds) {
    LAS float* tile = (LAS float*)lds;
    unsigned char* ws = p.ws;
    int item = opaque_bid(); const int stride = gridDim.x; int before = 0;
    const float lam_init = 0.8f - 0.6f * __expf(-0.3f * (float)l);
    convert_matrix(p.w_in + (size_t)l * DM * INC, (bf16_t*)(ws + W_IN), DM, INC, 0, p.pre_mix_g + l * DM, 1.f, 0, before, item, stride, tile); before += (INC / 64) * (DM / 64);
    convert_matrix(p.w_a_out + (size_t)l * 512 * DM, (bf16_t*)(ws + W_A), 512, DM, 1, p.diff_head_g + l * 128, 1.f - lam_init, 0, before, item, stride, tile); before += (DM / 64) * (512 / 64);
    convert_matrix(p.w_b_out + (size_t)l * 512 * DM, (bf16_t*)(ws + W_B), 512, DM, 2, nullptr, 1.f, 0, before, item, stride, tile); before += (DM / 64) * (512 / 64);
    convert_matrix(p.w_mix_out + (size_t)l * DM * DM, (bf16_t*)(ws + W_MIX), DM, DM, 2, nullptr, 1.f, 0, before, item, stride, tile); before += (DM / 64) * (DM / 64);
    convert_matrix(p.w_up + (size_t)l * DM * UPC, (bf16_t*)(ws + W_UP), DM, UPC, 4, p.pre_ffn_g + l * DM, 1.f, 0, before, item, stride, tile); before += (UPC / 64) * (DM / 64);
    convert_matrix(p.w_down + (size_t)l * DFF * DM, (bf16_t*)(ws + W_DOWN), DFF, DM, 2, nullptr, 1.f, 0, before, item, stride, tile);
}

__device__ void rowpass(const float* __restrict__ xsrc, const float* __restrict__ add, const float* __restrict__ g, float* __restrict__ xdst, bf16_t* __restrict__ hb, int rows) {
    const int tid = opaque_tid(); const int lane = tid & 63, wv = tid >> 6;
    for (int r = opaque_bid() * 8 + wv; r < rows; r += gridDim.x * 8) {
        f32x4 xv[4];
#pragma unroll
        for (int i = 0; i < 4; ++i) xv[i] = *(const f32x4*)(xsrc + (size_t)r * DM + i * 256 + lane * 4);
        if (add) {
            f32x4 av[4]; float ss = 0.f;
#pragma unroll
            for (int i = 0; i < 4; ++i) { av[i] = *(const f32x4*)(add + (size_t)r * DM + i * 256 + lane * 4); ss += av[i][0] * av[i][0] + av[i][1] * av[i][1] + av[i][2] * av[i][2] + av[i][3] * av[i][3]; }
            ss = wave_sum(ss);
            const float rs = __builtin_amdgcn_rsqf(ss * (1.f / DM) + EPS);
#pragma unroll
            for (int i = 0; i < 4; ++i) { const f32x4 gv = *(const f32x4*)(g + i * 256 + lane * 4);
                xv[i] = xv[i] + av[i] * gv * rs;
                *(f32x4*)(xdst + (size_t)r * DM + i * 256 + lane * 4) = xv[i]; }
        }
        if (hb) {
            float ss = 0.f;
#pragma unroll
            for (int i = 0; i < 4; ++i) ss += xv[i][0] * xv[i][0] + xv[i][1] * xv[i][1] + xv[i][2] * xv[i][2] + xv[i][3] * xv[i][3];
            ss = wave_sum(ss);
            const float rs = __builtin_amdgcn_rsqf(ss * (1.f / DM) + EPS);
#pragma unroll
            for (int i = 0; i < 4; ++i) { u32x2 o = {pack2(xv[i][0] * rs, xv[i][1] * rs), pack2(xv[i][2] * rs, xv[i][3] * rs)};
                *(u32x2*)(hb + (size_t)r * DM + i * 256 + lane * 4) = o; }
        }
    }
}

struct AttnJob {
    const bf16_t* Q; const bf16_t* K; const bf16_t* V;
    int t0, dil, n, jt0, jt1, W;
    bf16_t* O; int ldo; float* lse; float lam;
};
constexpr int KSTR = 272, VSTR = 288, KBYTES = 64 * KSTR, VBYTES = 64 * VSTR, ABUF = KBYTES + VBYTES;

template <int NC>
__device__ __forceinline__ void attn_job(const AttnJob& J, LAS unsigned char* lds) {
    const int tid = opaque_tid(), lane = tid & 63, w = __builtin_amdgcn_readfirstlane(tid >> 6), li = lane & 15, g = lane >> 4;
    const int qidx = J.n * 128 + w * 16 + li;
    const size_t qtok = (size_t)J.t0 + (size_t)J.dil * qidx;
    bf16x8 qf[4];
    { const bf16_t* qp = J.Q + qtok * INC + 8 * g;
#pragma unroll
      for (int f = 0; f < 4; ++f) qf[f] = *(const bf16x8*)(qp + f * 32); }
    f32x4 oacc[NC][8];
#pragma unroll
    for (int c = 0; c < NC; ++c)
#pragma unroll
        for (int d = 0; d < 8; ++d) oacc[c][d] = (f32x4){0.f, 0.f, 0.f, 0.f};
    float mrun[NC], lrun[NC];
#pragma unroll
    for (int c = 0; c < NC; ++c) { mrun[c] = -INFINITY; lrun[c] = 0.f; }

    const int srow = tid >> 4, sch = tid & 15;
    u32x4 kst[2], vst[2];
    auto gload = [&](int j) {
#pragma unroll
        for (int i = 0; i < 2; ++i) { const size_t tok = (size_t)J.t0 + (size_t)J.dil * (64 * j + srow + 32 * i);
            kst[i] = *(const u32x4*)(J.K + tok * INC + sch * 8); vst[i] = *(const u32x4*)(J.V + tok * INC + sch * 8); }
    };
    auto lstore = [&](int b) {
#pragma unroll
        for (int i = 0; i < 2; ++i) { *(LAS u32x4*)(lds + b * ABUF + (srow + 32 * i) * KSTR + sch * 16) = kst[i];
            *(LAS u32x4*)(lds + b * ABUF + KBYTES + (srow + 32 * i) * VSTR + sch * 16) = vst[i]; }
    };
    gload(J.jt0); lstore(0);
    __syncthreads();
    const int qlo = J.n * 128 + w * 16, qhi = qlo + 15;
    for (int j = J.jt0; j < J.jt1; ++j) {
        const int cb = (j - J.jt0) & 1;
        const bool more = (j + 1 < J.jt1);
        if (more) gload(j + 1);
        const int relmax = qhi - 64 * j, relmin = qlo - (64 * j + 63);
        if (relmax >= 0 && relmin <= J.W) {
            const bool needmask = (relmin < 0) || (relmax > J.W);
            LAS unsigned char* kb_ = lds + cb * ABUF; LAS unsigned char* vb_ = kb_ + KBYTES;
            f32x4 sacc[NC][4];
#pragma unroll
            for (int c = 0; c < NC; ++c)
#pragma unroll
                for (int kb = 0; kb < 4; ++kb) sacc[c][kb] = (f32x4){0.f, 0.f, 0.f, 0.f};
#pragma unroll
            for (int kb = 0; kb < 4; ++kb)
#pragma unroll
                for (int f = 0; f < 4; ++f) {
                    const bf16x8 kf = *(const LAS bf16x8*)(kb_ + (kb * 16 + li) * KSTR + (f * 32 + 8 * g) * 2);
                    const int c = (NC == 2) ? (f >> 1) : 0;
                    sacc[c][kb] = __builtin_amdgcn_mfma_f32_16x16x32_bf16(kf, qf[f], sacc[c][kb], 0, 0, 0);
                }
            bf16x8 pf[NC][2];
#pragma unroll
            for (int c = 0; c < NC; ++c) {
                if (needmask) {
#pragma unroll
                    for (int kb = 0; kb < 4; ++kb)
#pragma unroll
                        for (int r = 0; r < 4; ++r) { const int rel = qidx - (64 * j + 16 * kb + 4 * g + r);
                            if (rel < 0 || rel > J.W) sacc[c][kb][r] = -INFINITY; }
                }
                float tm = -INFINITY;
#pragma unroll
                for (int kb = 0; kb < 4; ++kb)
#pragma unroll
                    for (int r = 0; r < 4; ++r) tm = fmaxf(tm, sacc[c][kb][r]);
                tm = fmaxf(tm, __shfl_xor(tm, 16)); tm = fmaxf(tm, __shfl_xor(tm, 32));
                const float mnew = fmaxf(mrun[c], tm);
                const float muse = (mnew == -INFINITY) ? 0.f : mnew;
                const float alpha = __builtin_amdgcn_exp2f(mrun[c] - muse);
                mrun[c] = mnew;
                float ps = 0.f;
                float pv[4][4];
#pragma unroll
                for (int kb = 0; kb < 4; ++kb)
#pragma unroll
                    for (int r = 0; r < 4; ++r) { pv[kb][r] = __builtin_amdgcn_exp2f(sacc[c][kb][r] - muse); ps += pv[kb][r]; }
                lrun[c] = lrun[c] * alpha + ps;
#pragma unroll
                for (int d = 0; d < 8; ++d) oacc[c][d] = oacc[c][d] * alpha;
#pragma unroll
                for (int kk = 0; kk < 2; ++kk) {
                    u32x4 pk = {pack2(pv[2 * kk][0], pv[2 * kk][1]), pack2(pv[2 * kk][2], pv[2 * kk][3]),
                                pack2(pv[2 * kk + 1][0], pv[2 * kk + 1][1]), pack2(pv[2 * kk + 1][2], pv[2 * kk + 1][3])};
                    pf[c][kk] = __builtin_bit_cast(bf16x8, pk);
                }
            }
#pragma unroll
            for (int kk = 0; kk < 2; ++kk)
#pragma unroll
                for (int d = 0; d < 8; ++d) {
                    LAS unsigned char* vp = vb_ + (kk * 32 + 4 * g + (li >> 2)) * VSTR + (li & 3) * 8 + d * 32;
                    const s16x4 lo = __builtin_amdgcn_ds_read_tr16_b64_v4i16((LAS s16x4*)vp);
                    const s16x4 hi = __builtin_amdgcn_ds_read_tr16_b64_v4i16((LAS s16x4*)(vp + 16 * VSTR));
                    const bf16x8 vf = {lo[0], lo[1], lo[2], lo[3], hi[0], hi[1], hi[2], hi[3]};
#pragma unroll
                    for (int c = 0; c < NC; ++c) oacc[c][d] = __builtin_amdgcn_mfma_f32_16x16x32_bf16(vf, pf[c][kk], oacc[c][d], 0, 0, 0);
                }
        }
        if (more) lstore(cb ^ 1);
        __syncthreads();
    }
    float linv[NC];
#pragma unroll
    for (int c = 0; c < NC; ++c) { float l = lrun[c]; l += __shfl_xor(l, 16); l += __shfl_xor(l, 32); lrun[c] = l; linv[c] = 1.f / l; }
    bf16_t* op = J.O + qtok * J.ldo + 4 * g;
    if (NC == 2) {
        float ss = 0.f;
#pragma unroll
        for (int d = 0; d < 8; ++d)
#pragma unroll
            for (int r = 0; r < 4; ++r) { const float v = oacc[0][d][r] * linv[0] - J.lam * oacc[NC - 1][d][r] * linv[NC - 1]; oacc[0][d][r] = v; ss += v * v; }
        ss += __shfl_xor(ss, 16); ss += __shfl_xor(ss, 32);
        const float rs = __builtin_amdgcn_rsqf(ss * (1.f / 128.f) + EPS);
#pragma unroll
        for (int d = 0; d < 8; ++d) { u32x2 o = {pack2(oacc[0][d][0] * rs, oacc[0][d][1] * rs), pack2(oacc[0][d][2] * rs, oacc[0][d][3] * rs)};
            *(u32x2*)(op + 16 * d) = o; }
    } else {
#pragma unroll
        for (int d = 0; d < 8; ++d) { u32x2 o = {pack2(oacc[0][d][0] * linv[0], oacc[0][d][1] * linv[0]), pack2(oacc[0][d][2] * linv[0], oacc[0][d][3] * linv[0])};
            *(u32x2*)(op + 16 * d) = o; }
        if (g == 0) J.lse[qtok * 4] = mrun[0] + __builtin_amdgcn_logf(lrun[0]);
    }
}

__device__ void attn_phase(const Params& p, int l, const bf16_t* proj, bf16_t* oab, bf16_t* og, float* lse, LAS unsigned char* lds) {
    const int nbl = p.Mc / SEQ;
    const int nA = nbl * 4 * 16, nB = nbl * 384;
    float lam;
    { const int lane = opaque_tid() & 63; const float* lv = p.diff_lambda + l * 256;
      const float s1 = wave_sum(lv[lane] * lv[64 + lane]), s2 = wave_sum(lv[128 + lane] * lv[192 + lane]);
      lam = __expf(s1) - __expf(s2) + (0.8f - 0.6f * __expf(-0.3f * (float)l)); }
    for (int it = opaque_bid(); it < nA + nB; it += gridDim.x) {
        if (it < nA) {
            const int bh = it >> 4, pi = it & 15, bl = bh >> 2, h = bh & 3;
            const bf16_t* base = proj + (size_t)bl * SEQ * INC;
            for (int pass = 0; pass < 2; ++pass) {
                AttnJob J; J.Q = base + h * 128; J.K = base + 512 + h * 128; J.V = base + 1024 + h * 128;
                J.t0 = 0; J.dil = 1; J.n = pass == 0 ? 31 - pi : pi; J.jt0 = 0; J.jt1 = 2 * J.n + 2; J.W = 1 << 30;
                J.O = oab + (size_t)bl * SEQ * DM + h * 128; J.ldo = DM; J.lse = nullptr; J.lam = lam;
                attn_job<2>(J, lds);
            }
        } else {
            const int id = it - nA; const int bl = id / 384, rem = id % 384, gi = rem >> 7, h = (rem & 127) >> 5, idx = rem & 31;
            const int dil = 1 << (2 * gi), r = idx & (dil - 1), nblk = idx >> (2 * gi);
            const bf16_t* base = proj + (size_t)bl * SEQ * INC;
            AttnJob J; J.Q = base + 1536 + gi * 512 + h * 128; J.K = base + 3072 + gi * 512 + h * 128; J.V = base + 4608 + gi * 512 + h * 128;
            J.t0 = r; J.dil = dil; J.n = nblk; J.jt0 = nblk == 0 ? 0 : 2 * nblk - 2; J.jt1 = 2 * nblk + 2; J.W = 128;
            J.O = og + ((size_t)gi * p.Mc + (size_t)bl * SEQ) * 512 + h * 128; J.ldo = 512; J.lse = lse + ((size_t)gi * p.Mc + (size_t)bl * SEQ) * 4 + h; J.lam = 0.f;
            attn_job<1>(J, lds);
        }
    }
}

__device__ void combine_phase(const Params& p, const bf16_t* og, const float* lse, bf16_t* oab) {
    const int tid = opaque_tid(); const int lane = tid & 63, wv = tid >> 6, h = lane >> 4;
    const size_t Mc = p.Mc;
    for (int r = opaque_bid() * 8 + wv; r < p.Mc; r += gridDim.x * 8) {
        const float l0 = lse[(size_t)r * 4 + h], l1 = lse[(Mc + r) * 4 + h], l2 = lse[(2 * Mc + r) * 4 + h];
        const float mx = fmaxf(l0, fmaxf(l1, l2));
        float w0 = __builtin_amdgcn_exp2f(l0 - mx), w1 = __builtin_amdgcn_exp2f(l1 - mx), w2 = __builtin_amdgcn_exp2f(l2 - mx);
        const float inv = 1.f / (w0 + w1 + w2); w0 *= inv; w1 *= inv; w2 *= inv;
        const u32x4 a = *(const u32x4*)(og + (size_t)r * 512 + lane * 8), b = *(const u32x4*)(og + (Mc + r) * 512 + lane * 8), c = *(const u32x4*)(og + (2 * Mc + r) * 512 + lane * 8);
        u32x4 o;
#pragma unroll
        for (int i = 0; i < 4; ++i) o[i] = pack2(w0 * bflo(a[i]) + w1 * bflo(b[i]) + w2 * bflo(c[i]), w0 * bfhi(a[i]) + w1 * bfhi(b[i]) + w2 * bfhi(c[i]));
        *(u32x4*)(oab + (size_t)r * DM + 512 + lane * 8) = o;
    }
}

__device__ __forceinline__ float gelu_tanh(float x) {
    const float t = 0.7978845608028654f * (x + 0.044715f * x * x * x);
    return x * __builtin_amdgcn_rcpf(1.f + __builtin_amdgcn_exp2f(-2.f * LOG2E * t));
}
__device__ void convglu_phase(const Params& p, int l, const bf16_t* u, bf16_t* a) {
    const int ncg = DFF / 4; const int nitems = (p.Mc / 16) * ncg;
    const float* cw = p.conv_w + (size_t)l * 3 * UPC; const float* cb = p.conv_b + (size_t)l * UPC;
    for (int item = opaque_bid() * 512 + opaque_tid(); item < nitems; item += gridDim.x * 512) {
        const int cg_ = item % ncg, tg = item / ncg; const int j0 = cg_ * 4, t0 = tg * 16;
        f32x4 wg[3], wv[3];
#pragma unroll
        for (int t = 0; t < 3; ++t) { wg[t] = *(const f32x4*)(cw + t * UPC + j0); wv[t] = *(const f32x4*)(cw + t * UPC + DFF + j0); }
        const f32x4 bg = *(const f32x4*)(cb + j0), bv = *(const f32x4*)(cb + DFF + j0);
        f32x4 g2 = {0.f, 0.f, 0.f, 0.f}, v2 = g2, g1 = g2, v1 = g2;
        if ((t0 & (SEQ - 1)) != 0) {
            const u32x4 r2 = *(const u32x4*)(u + (size_t)(t0 - 2) * UPC + 2 * j0), r1 = *(const u32x4*)(u + (size_t)(t0 - 1) * UPC + 2 * j0);
#pragma unroll
            for (int k = 0; k < 4; ++k) { g2[k] = bflo(r2[k]); v2[k] = bfhi(r2[k]); g1[k] = bflo(r1[k]); v1[k] = bfhi(r1[k]); }
        }
#pragma unroll 4
        for (int i = 0; i < 16; ++i) {
            const u32x4 rc = *(const u32x4*)(u + (size_t)(t0 + i) * UPC + 2 * j0);
            f32x4 g0, v0;
#pragma unroll
            for (int k = 0; k < 4; ++k) { g0[k] = bflo(rc[k]); v0[k] = bfhi(rc[k]); }
            const f32x4 cgv = wg[0] * g2 + wg[1] * g1 + wg[2] * g0 + bg;
            const f32x4 cvv = wv[0] * v2 + wv[1] * v1 + wv[2] * v0 + bv;
            u32x2 o = {pack2(gelu_tanh(cgv[0]) * cvv[0], gelu_tanh(cgv[1]) * cvv[1]), pack2(gelu_tanh(cgv[2]) * cvv[2], gelu_tanh(cgv[3]) * cvv[3])};
            *(u32x2*)(a + (size_t)(t0 + i) * DFF + j0) = o;
            g2 = g1; v2 = v1; g1 = g0; v1 = v0;
        }
    }
}

__device__ __forceinline__ void run_step(const Params& p, int step, LAS unsigned char* lds) {
    unsigned char* ws = p.ws;
    bf16_t* HB = (bf16_t*)(ws + WS_HB);
    const size_t Mc = p.Mc;
    unsigned char* R1 = ws + WS_CH; unsigned char* R2 = R1 + Mc * 16896; unsigned char* R3 = R2 + Mc * 2048; float* LSE = (float*)(R3 + Mc * 5120);
    bf16_t* proj = (bf16_t*)R1; bf16_t* ubuf = (bf16_t*)R1; bf16_t* abuf = (bf16_t*)(R1 + Mc * 11264);
    bf16_t* zbuf = (bf16_t*)R2; bf16_t* hb2 = (bf16_t*)R2;
    bf16_t* oab = (bf16_t*)R3; bf16_t* og = (bf16_t*)(R3 + Mc * 2048); float* mix = (float*)R3;
    if (step == 0) {
        if (!PH_EN(100)) return;
        rowpass(p.x_in, nullptr, nullptr, nullptr, HB, NTOK);
        convert_weights(p, 0, lds);
        return;
    }
    const int s1 = step - 1; const int ph = s1 % NPH; const int lc = s1 / NPH; const int c = lc % p.nchunk, l = lc / p.nchunk;
    const size_t row0 = (size_t)c * Mc;
    pg8::StaticOrder S;
    switch (ph) {
    case 0: if (PH_EN(0)) { pg8::Gemm g{HB + row0 * DM, (const bf16_t*)(ws + W_IN), (int)Mc, INC, DM, DM}; S.init((int)Mc, INC, gridDim.x, opaque_bid());
              pg8::EpiProj E{proj, p.pos + row0}; pg8::gemm_phase(lds, g, S, E); } break;
    case 1: if (PH_EN(1)) attn_phase(p, l, proj, oab, og, LSE, lds); break;
    case 2: if (PH_EN(2)) combine_phase(p, og, LSE, oab); break;
    case 3: if (PH_EN(3)) { pg8::Gemm g{oab, (const bf16_t*)(ws + W_A), (int)Mc, DM, 512, DM}; S.init((int)Mc, DM, gridDim.x, opaque_bid());
              pg8::EpiGate<0> E{zbuf, proj, 6144}; pg8::gemm_phase(lds, g, S, E); } break;
    case 4: if (PH_EN(4)) { pg8::Gemm g{oab + 512, (const bf16_t*)(ws + W_B), (int)Mc, DM, 512, DM}; S.init((int)Mc, DM, gridDim.x, opaque_bid());
              pg8::EpiGate<1> E{zbuf, proj, 7168}; pg8::gemm_phase(lds, g, S, E); } break;
    case 5: if (PH_EN(5)) { pg8::Gemm g{zbuf, (const bf16_t*)(ws + W_MIX), (int)Mc, DM, DM, DM}; S.init((int)Mc, DM, gridDim.x, opaque_bid());
              pg8::EpiF32 E{mix, DM}; pg8::gemm_phase(lds, g, S, E); } break;
    case 6: if (PH_EN(6)) rowpass((l == 0 ? p.x_in : p.out) + row0 * DM, mix, p.post_mix_g + l * DM, p.out + row0 * DM, hb2, (int)Mc); break;
    case 7: if (PH_EN(7)) { pg8::Gemm g{hb2, (const bf16_t*)(ws + W_UP), (int)Mc, UPC, DM, DM}; S.init((int)Mc, UPC, gridDim.x, opaque_bid());
              pg8::EpiBf16 E{ubuf, UPC}; pg8::gemm_phase(lds, g, S, E); } break;
    case 8: if (PH_EN(8)) convglu_phase(p, l, ubuf, abuf); break;
    case 9: if (PH_EN(9)) { pg8::Gemm g{abuf, (const bf16_t*)(ws + W_DOWN), (int)Mc, DM, DFF, DFF}; S.init((int)Mc, DM, gridDim.x, opaque_bid());
              pg8::EpiF32 E{mix, DM}; pg8::gemm_phase(lds, g, S, E); } break;
    case 10: if (PH_EN(10)) { rowpass(p.out + row0 * DM, mix, p.post_ffn_g + l * DM, p.out + row0 * DM, (l + 1 < DEPTH) ? HB + row0 * DM : nullptr, (int)Mc);
             if (c == p.nchunk - 1 && l + 1 < DEPTH) convert_weights(p, l + 1, lds); }
             break;
    }
}

template <bool COOP>
__global__ void __launch_bounds__(512, 2) mk_fwd(Params p) {
    extern __shared__ __attribute__((aligned(16))) unsigned char smem[];
    LAS unsigned char* lds = (LAS unsigned char*)smem;
    for (int step = p.ph_lo; step < p.ph_hi; ++step) {
        run_step(p, step, lds);
        if (COOP && step + 1 < p.ph_hi) { cg::this_grid().sync(); }
    }
}

extern "C" void kernel_launch(void* const* d_in, const int* in_sizes, int n_in, void* d_out, int out_size, void* d_ws, size_t ws_size, hipStream_t stream) {
    static int grid = 0; static int Mc = 0;
    if (grid == 0) {
        int dev = 0, cus = 0, per_cu = 0;
        hipGetDevice(&dev);
        hipDeviceGetAttribute(&cus, hipDeviceAttributeMultiprocessorCount, dev);
        hipFuncSetAttribute((const void*)mk_fwd<true>, hipFuncAttributeMaxDynamicSharedMemorySize, LDS_BYTES);
        hipFuncSetAttribute((const void*)mk_fwd<false>, hipFuncAttributeMaxDynamicSharedMemorySize, LDS_BYTES);
        hipOccupancyMaxActiveBlocksPerMultiprocessor(&per_cu, (const void*)mk_fwd<true>, 512, LDS_BYTES);
        if (per_cu < 1) per_cu = 1;
        grid = cus * per_cu;
        Mc = NTOK;
        while (Mc > SEQ && WS_CH + (size_t)Mc * PER_TOK > ws_size) Mc >>= 1;
        fprintf(stderr, "kernel_launch: cus %d per_cu %d grid %d Mc %d ws %zu\n", cus, per_cu, grid, Mc, ws_size);
    }
    Params p{};
    p.x_in = (const float*)d_in[0]; p.pos = (const int*)d_in[1]; p.pre_mix_g = (const float*)d_in[2]; p.w_in = (const float*)d_in[3];
    p.diff_lambda = (const float*)d_in[4]; p.diff_head_g = (const float*)d_in[5]; p.w_a_out = (const float*)d_in[6]; p.w_b_out = (const float*)d_in[7];
    p.w_mix_out = (const float*)d_in[8]; p.post_mix_g = (const float*)d_in[9]; p.pre_ffn_g = (const float*)d_in[10]; p.w_up = (const float*)d_in[11];
    p.conv_w = (const float*)d_in[12]; p.conv_b = (const float*)d_in[13]; p.w_down = (const float*)d_in[14]; p.post_ffn_g = (const float*)d_in[15];
    p.out = (float*)d_out; p.ws = (unsigned char*)d_ws; p.Mc = Mc; p.nchunk = NTOK / Mc;
    const int nsteps = 1 + DEPTH * p.nchunk * NPH;
#if MK_SINGLE
    p.ph_lo = 0; p.ph_hi = nsteps;
    void* args[] = {&p};
    hipError_t e = hipLaunchCooperativeKernel((const void*)mk_fwd<true>, dim3(grid), dim3(512), args, LDS_BYTES, stream);
    if (e != hipSuccess) fprintf(stderr, "cooperative launch failed: %s (grid %d)\n", hipGetErrorString(e), grid);
#else
    for (int s = 0; s < nsteps; ++s) {
        p.ph_lo = s; p.ph_hi = s + 1;
        hipLaunchKernelGGL(mk_fwd<false>, dim3(grid), dim3(512), LDS_BYTES, stream, p);
    }
#endif
    (void)in_sizes; (void)n_in; (void)out_size;
}
```

```cpp
#include <hip/hip_runtime.h>
#include <hip/hip_cooperative_groups.h>
#include <cstdio>
#include <cstdint>
namespace cg = cooperative_groups;

#ifndef MK_SINGLE
#define MK_SINGLE 1
#endif

#ifndef MK_ONLY
#define MK_ONLY -1
#endif
#define PH_EN(k) ((MK_ONLY) < 0 || (MK_ONLY) == (k))
#define LAS __attribute__((address_space(3)))
typedef unsigned short bf16_t;
typedef short bf16x8 __attribute__((ext_vector_type(8)));
typedef short s16x4 __attribute__((ext_vector_type(4)));
typedef float f32x4 __attribute__((ext_vector_type(4)));
typedef float f32x2 __attribute__((ext_vector_type(2)));
typedef unsigned u32x4 __attribute__((ext_vector_type(4)));
typedef unsigned u32x2 __attribute__((ext_vector_type(2)));
typedef __bf16 bf2_t __attribute__((ext_vector_type(2)));

constexpr int DM = 1024, NBATCH = 8, SEQ = 4096, DEPTH = 4, NTOK = NBATCH * SEQ, INC = 8192, DFF = 2816, UPC = 2 * DFF;
constexpr float EPS = 1e-6f;
constexpr float LOG2E = 1.4426950408889634f;
constexpr int NPH = 11;
constexpr int LDS_MAIN = 131072;
constexpr int LDS_BYTES = LDS_MAIN + 16;

constexpr size_t W_IN = 0, W_A = W_IN + (size_t)INC * DM * 2, W_B = W_A + (size_t)DM * 512 * 2, W_MIX = W_B + (size_t)DM * 512 * 2,
                 W_UP = W_MIX + (size_t)DM * DM * 2, W_DOWN = W_UP + (size_t)UPC * DM * 2, W_END = W_DOWN + (size_t)DM * DFF * 2;
constexpr size_t WS_BAR = (W_END + 255) & ~(size_t)255;
constexpr size_t WS_BAR_BYTES = 16384;
constexpr size_t WS_HB = WS_BAR + WS_BAR_BYTES;
constexpr size_t WS_CH = WS_HB + (size_t)NTOK * DM * 2;
constexpr size_t PER_TOK = 16896 + 2048 + 5120 + 48;

struct Params {
    const float* x_in; const int* pos; const float* pre_mix_g; const float* w_in; const float* diff_lambda; const float* diff_head_g;
    const float* w_a_out; const float* w_b_out; const float* w_mix_out; const float* post_mix_g; const float* pre_ffn_g;
    const float* w_up; const float* conv_w; const float* conv_b; const float* w_down; const float* post_ffn_g;
    float* out; unsigned char* ws;
    int Mc, nchunk, ph_lo, ph_hi;
};

__device__ __forceinline__ unsigned pack2(float a, float b) { f32x2 v = {a, b}; bf2_t r = __builtin_convertvector(v, bf2_t); return __builtin_bit_cast(unsigned, r); }
__device__ __forceinline__ float bflo(unsigned u) { return __uint_as_float(u << 16); }
__device__ __forceinline__ float bfhi(unsigned u) { return __uint_as_float(u & 0xffff0000u); }
__device__ __forceinline__ int opaque_tid() { int t = threadIdx.x; asm volatile("" : "+v"(t)); return t; }
__device__ __forceinline__ int opaque_bid() { int t = blockIdx.x; asm volatile("" : "+s"(t)); return t; }
__device__ __forceinline__ float wave_sum(float v) {
#pragma unroll
    for (int o = 32; o > 0; o >>= 1) v += __shfl_xor(v, o);
    return v;
}

namespace pg8 {
constexpr int BM = 256, BK = 64, HALF = 128, HTB = HALF * BK * 2, STAGE_BYTES = 8 * HTB, NXCD = 8, WGM = 8;
__device__ __forceinline__ int lds_byte(int r, int c) { const int st = (r >> 4) * 2 + (c >> 5), rr = r & 15, cc = c & 31, ob = rr * 64 + cc * 2; return st * 1024 + (ob ^ (((ob >> 9) & 1) << 5)); }
__device__ __forceinline__ void stage_rc(int b, int& R, int& C) { const int st = b / 1024, sb = b % 1024, swz = sb ^ (((sb >> 9) & 1) << 5); R = (st >> 1) * 16 + swz / 64; C = (st & 1) * 32 + (swz % 64) / 2; }
__device__ __forceinline__ int perm32(int rho) { const int n = rho >> 4, i = rho & 15; return 8 * (i >> 2) + 4 * n + (i & 3); }

struct Unit { int pm, pn; };
struct Gemm { const bf16_t* A; const bf16_t* Bt; int M, N, K, lda; };

struct StaticOrder {
    int nM, nN, nwg, G, c;
    __device__ void init(int M, int N, int G_, int c_) { nM = M / BM; nN = N / BM; nwg = nM * nN; G = G_; c = c_; }
    __device__ bool next(int i, Unit& u) const {
        const long L = (long)i * G + c; if (L >= nwg) return false;
        int wgid = (int)L; { const int q = nwg / NXCD, r = nwg % NXCD, xcd = wgid % NXCD, off = wgid / NXCD; wgid = (xcd < r ? xcd * (q + 1) : r * (q + 1) + (xcd - r) * q) + off; }
        const int nig = WGM * nN, gid = wgid / nig, fm = gid * WGM, gsz = (nM - fm) < WGM ? (nM - fm) : WGM;
        u.pm = fm + ((wgid % nig) % gsz); u.pn = (wgid % nig) / gsz; return true;
    }
};

template <class Epi>
__device__ __forceinline__ void gemm_phase(LAS unsigned char* lds, const Gemm g, const StaticOrder& S, const Epi& E) {
    const int tid = opaque_tid(), wid = __builtin_amdgcn_readfirstlane(tid >> 6), lane = tid & 63, wr = wid >> 2, wc = wid & 3, fr = lane & 15, fq = lane >> 4;
    const int K = g.K, nt = K / BK, lda = g.lda;
    unsigned voffA[2], voffB[2];
#pragma unroll
    for (int i = 0; i < 2; ++i) { int R, C; stage_rc(tid * 16 + i * 8192, R, C); const int Rb = Epi::PERM ? ((R & ~31) + perm32(R & 31)) : R;
        voffA[i] = (unsigned)(R * lda + C) * 2u; voffB[i] = (unsigned)(Rb * K + C) * 2u; }
    const size_t kstep = (size_t)(BK * 2);
    const size_t hstepA = (size_t)HALF * lda * 2, hstepB = (size_t)HALF * K * 2;
    const size_t tstepA = 2 * hstepA, tstepB = 2 * hstepB;
    const unsigned ldsw = (unsigned)wid * 1024u;
    const int aoff = lds_byte(wr * 64 + fr, fq * 8), boff = lds_byte(wc * 32 + fr, fq * 8);
#define PG8_SA(b, h) (((b) * 2 + (h)) * HTB)
#define PG8_SB(b, h) ((4 + (b) * 2 + (h)) * HTB)
#define PG8_STAGE(bufoff, gbase, voff) do { _Pragma("unroll") for (int _i = 0; _i < 2; ++_i) \
        __builtin_amdgcn_global_load_lds((const unsigned*)((const char*)(gbase) + (voff)[_i]), (LAS unsigned*)(lds + (bufoff) + ldsw + _i * 8192), 16, 0, 0); } while (0)
#define PG8_LDA(dst, b, h) do { _Pragma("unroll") for (int m = 0; m < 4; ++m) _Pragma("unroll") for (int k = 0; k < 2; ++k) dst[m][k] = *(const LAS bf16x8*)(lds + PG8_SA(b, h) + aoff + m * 2048 + k * 1024); } while (0)
#define PG8_LDB(dst, b, h) do { _Pragma("unroll") for (int n = 0; n < 2; ++n) _Pragma("unroll") for (int k = 0; k < 2; ++k) dst[n][k] = *(const LAS bf16x8*)(lds + PG8_SB(b, h) + boff + n * 2048 + k * 1024); } while (0)
#define PG8_MMA(ai, bj, At, Bt) do { __builtin_amdgcn_s_setprio(1); _Pragma("unroll") for (int m = 0; m < 4; ++m) _Pragma("unroll") for (int n = 0; n < 2; ++n) _Pragma("unroll") for (int k = 0; k < 2; ++k) \
        acc[ai][bj][m][n] = __builtin_amdgcn_mfma_f32_16x16x32_bf16(Bt[n][k], At[m][k], acc[ai][bj][m][n], 0, 0, 0); __builtin_amdgcn_s_setprio(0); } while (0)
#define PG8_WAIT_V(n) asm volatile("s_waitcnt vmcnt(" #n ")" ::: "memory")
#define PG8_WAIT_L(n) asm volatile("s_waitcnt lgkmcnt(" #n ")" ::: "memory")
#define PG8_BAR __builtin_amdgcn_s_barrier()
#define PG8_SCHED __builtin_amdgcn_sched_barrier(0)
    Unit cur, nxt; int ui = 0;
    if (!S.next(0, cur)) return;
    f32x4 acc[2][2][4][2];
#pragma unroll
    for (int a = 0; a < 2; ++a)
#pragma unroll
        for (int b = 0; b < 2; ++b)
#pragma unroll
            for (int m = 0; m < 4; ++m)
#pragma unroll
                for (int n = 0; n < 2; ++n) acc[a][b][m][n] = (f32x4){0.f, 0.f, 0.f, 0.f};
    bf16x8 At[4][2], B0[2][2], B1[2][2];
    const char* cA = (const char*)g.A + (size_t)cur.pm * tstepA; const char* cB = (const char*)g.Bt + (size_t)cur.pn * tstepB;
    PG8_STAGE(PG8_SB(0, 0), cB, voffB); PG8_STAGE(PG8_SA(0, 0), cA, voffA); PG8_STAGE(PG8_SB(0, 1), cB + hstepB, voffB); PG8_STAGE(PG8_SA(0, 1), cA + hstepA, voffA);
    if (wr == 1) PG8_BAR;
    PG8_WAIT_V(4); PG8_BAR;
    PG8_STAGE(PG8_SB(1, 0), cB + kstep, voffB); PG8_STAGE(PG8_SA(1, 0), cA + kstep, voffA); PG8_STAGE(PG8_SB(1, 1), cB + hstepB + kstep, voffB);
    PG8_WAIT_V(6); PG8_BAR;
    for (;;) {
        const bool has_next = S.next(ui + 1, nxt);
        const char* nA = has_next ? (const char*)g.A + (size_t)nxt.pm * tstepA : cA; const char* nB = has_next ? (const char*)g.Bt + (size_t)nxt.pn * tstepB : cB;
        for (int t = 0; t < nt; t += 2) {
            const bool last = (t == nt - 2);
            const char* a1 = cA + (size_t)(t + 1) * kstep;
            const char* a2 = last ? nA : cA + (size_t)(t + 2) * kstep; const char* b2 = last ? nB : cB + (size_t)(t + 2) * kstep;
            const char* a3 = a2 + kstep; const char* b3 = b2 + kstep;
            PG8_LDB(B0, 0, 0); PG8_SCHED; PG8_LDA(At, 0, 0); PG8_STAGE(PG8_SA(1, 1), a1 + hstepA, voffA);
            PG8_WAIT_L(8); PG8_BAR; PG8_WAIT_L(0); PG8_MMA(0, 0, At, B0); PG8_BAR; PG8_SCHED;
            PG8_LDB(B1, 0, 1); PG8_STAGE(PG8_SB(0, 0), b2, voffB);
            PG8_BAR; PG8_WAIT_L(0); PG8_MMA(0, 1, At, B1); PG8_BAR;
            PG8_LDA(At, 0, 1); PG8_STAGE(PG8_SA(0, 0), a2, voffA);
            PG8_BAR; PG8_WAIT_L(0); PG8_MMA(1, 0, At, B0); PG8_BAR; PG8_SCHED;
            PG8_STAGE(PG8_SB(0, 1), b2 + hstepB, voffB);
            PG8_WAIT_V(6); PG8_BAR; PG8_MMA(1, 1, At, B1); PG8_BAR;
            PG8_LDB(B0, 1, 0); PG8_SCHED; PG8_LDA(At, 1, 0); PG8_STAGE(PG8_SA(0, 1), a2 + hstepA, voffA);
            PG8_WAIT_L(8); PG8_BAR; PG8_WAIT_L(0); PG8_MMA(0, 0, At, B0); PG8_BAR; PG8_SCHED;
            PG8_LDB(B1, 1, 1); PG8_STAGE(PG8_SB(1, 0), b3, voffB);
            PG8_BAR; PG8_WAIT_L(0); PG8_MMA(0, 1, At, B1); PG8_BAR;
            PG8_LDA(At, 1, 1); PG8_STAGE(PG8_SA(1, 0), a3, voffA);
            PG8_BAR; PG8_WAIT_L(0); PG8_MMA(1, 0, At, B0); PG8_BAR; PG8_SCHED;
            PG8_STAGE(PG8_SB(1, 1), b3 + hstepB, voffB);
            PG8_WAIT_V(6); PG8_BAR; PG8_MMA(1, 1, At, B1); PG8_BAR;
        }
        E(acc, cur, wr, wc, fr, fq);
        if (!has_next) break;
#pragma unroll
        for (int a = 0; a < 2; ++a)
#pragma unroll
            for (int b = 0; b < 2; ++b)
#pragma unroll
                for (int m = 0; m < 4; ++m)
#pragma unroll
                    for (int n = 0; n < 2; ++n) acc[a][b][m][n] = (f32x4){0.f, 0.f, 0.f, 0.f};
        cur = nxt; cA = nA; cB = nB; ++ui;
    }
    PG8_WAIT_V(0);
    if (wr == 0) PG8_BAR;
    PG8_BAR;
#undef PG8_SA
#undef PG8_SB
#undef PG8_STAGE
#undef PG8_LDA
#undef PG8_LDB
#undef PG8_MMA
#undef PG8_WAIT_V
#undef PG8_WAIT_L
#undef PG8_BAR
#undef PG8_SCHED
}

struct EpiProj {
    static constexpr bool PERM = true;
    bf16_t* O; const int* pos;
    __device__ __forceinline__ void operator()(const f32x4 (&acc)[2][2][4][2], const Unit& u, int wr, int wc, int fr, int fq) const {
        const int pn = u.pn;
        int type;
        if (pn < 4) type = 1; else if (pn < 6) type = 0; else if (pn < 18) type = 2; else if (pn < 24) type = 0; else type = 3;
        float inv[2][4];
#pragma unroll
        for (int bj = 0; bj < 2; ++bj)
#pragma unroll
            for (int i = 0; i < 4; ++i) inv[bj][i] = 0.f;
        if (type == 1 || type == 2) {
            const int dim = type == 1 ? 64 : 128;
            const float c1 = (type == 1 ? (2.f / 64.f) : (2.f / 128.f)) * 13.287712379549449f;
#pragma unroll
            for (int bj = 0; bj < 2; ++bj) {
                const int col = pn * 256 + bj * 128 + wc * 32 + 8 * fq; const int jf0 = (col & (dim - 1)) >> 1;
#pragma unroll
                for (int i = 0; i < 4; ++i) inv[bj][i] = __builtin_amdgcn_exp2f(-(float)(jf0 + i) * c1 - 2.651496129472319f);
            }
        }
#pragma unroll
        for (int ai = 0; ai < 2; ++ai)
#pragma unroll
            for (int m = 0; m < 4; ++m) {
                const int row = u.pm * 256 + ai * 128 + wr * 64 + m * 16 + fr;
                const float posf = (float)pos[row];
#pragma unroll
                for (int bj = 0; bj < 2; ++bj) {
                    const int col = pn * 256 + bj * 128 + wc * 32 + 8 * fq;
                    f32x4 v0 = acc[ai][bj][m][0], v1 = acc[ai][bj][m][1];
                    float v[8] = {v0[0], v0[1], v0[2], v0[3], v1[0], v1[1], v1[2], v1[3]};
                    if (type == 1 || type == 2) {
#pragma unroll
                        for (int i = 0; i < 4; ++i) {
                            float rev = posf * inv[bj][i]; rev -= __builtin_rintf(rev);
                            const float sn = __builtin_amdgcn_sinf(rev), cs = __builtin_amdgcn_cosf(rev);
                            const float x1 = v[2 * i], x2 = v[2 * i + 1];
                            v[2 * i] = x1 * cs - x2 * sn; v[2 * i + 1] = x2 * cs + x1 * sn;
                        }
                    } else if (type == 3) {
#pragma unroll
                        for (int i = 0; i < 8; ++i) v[i] = __builtin_amdgcn_rcpf(1.f + __builtin_amdgcn_exp2f(-v[i] * LOG2E));
                    }
                    u32x4 o = {pack2(v[0], v[1]), pack2(v[2], v[3]), pack2(v[4], v[5]), pack2(v[6], v[7])};
                    *(u32x4*)(O + (size_t)row * INC + col) = o;
                }
            }
    }
};
struct EpiBf16 {
    static constexpr bool PERM = true;
    bf16_t* O; int ldc;
    __device__ __forceinline__ void operator()(const f32x4 (&acc)[2][2][4][2], const Unit& u, int wr, int wc, int fr, int fq) const {
#pragma unroll
        for (int ai = 0; ai < 2; ++ai)
#pragma unroll
            for (int m = 0; m < 4; ++m) {
                const int row = u.pm * 256 + ai * 128 + wr * 64 + m * 16 + fr;
#pragma unroll
                for (int bj = 0; bj < 2; ++bj) {
                    const int col = u.pn * 256 + bj * 128 + wc * 32 + 8 * fq;
                    f32x4 v0 = acc[ai][bj][m][0], v1 = acc[ai][bj][m][1];
                    u32x4 o = {pack2(v0[0], v0[1]), pack2(v0[2], v0[3]), pack2(v1[0], v1[1]), pack2(v1[2], v1[3])};
                    *(u32x4*)(O + (size_t)row * ldc + col) = o;
                }
            }
    }
};
template <int MODE> struct EpiGate {
    static constexpr bool PERM = true;
    bf16_t* Z; const bf16_t* P; int goff;
    __device__ __forceinline__ void operator()(const f32x4 (&acc)[2][2][4][2], const Unit& u, int wr, int wc, int fr, int fq) const {
#pragma unroll
        for (int ai = 0; ai < 2; ++ai)
#pragma unroll
            for (int m = 0; m < 4; ++m) {
                const int row = u.pm * 256 + ai * 128 + wr * 64 + m * 16 + fr;
#pragma unroll
                for (int bj = 0; bj < 2; ++bj) {
                    const int col = u.pn * 256 + bj * 128 + wc * 32 + 8 * fq;
                    f32x4 v0 = acc[ai][bj][m][0], v1 = acc[ai][bj][m][1];
                    const u32x4 gt = *(const u32x4*)(P + (size_t)row * INC + goff + col);
                    float r[8] = {v0[0] * bflo(gt[0]), v0[1] * bfhi(gt[0]), v0[2] * bflo(gt[1]), v0[3] * bfhi(gt[1]),
                                  v1[0] * bflo(gt[2]), v1[1] * bfhi(gt[2]), v1[2] * bflo(gt[3]), v1[3] * bfhi(gt[3])};
                    u32x4* zp = (u32x4*)(Z + (size_t)row * DM + col);
                    if (MODE == 1) { const u32x4 zo = *zp;
                        r[0] += bflo(zo[0]); r[1] += bfhi(zo[0]); r[2] += bflo(zo[1]); r[3] += bfhi(zo[1]);
                        r[4] += bflo(zo[2]); r[5] += bfhi(zo[2]); r[6] += bflo(zo[3]); r[7] += bfhi(zo[3]); }
                    u32x4 o = {pack2(r[0], r[1]), pack2(r[2], r[3]), pack2(r[4], r[5]), pack2(r[6], r[7])};
                    *zp = o;
                }
            }
    }
};
struct EpiF32 {
    static constexpr bool PERM = false;
    float* C; int ldc;
    __device__ __forceinline__ void operator()(const f32x4 (&acc)[2][2][4][2], const Unit& u, int wr, int wc, int fr, int fq) const {
#pragma unroll
        for (int ai = 0; ai < 2; ++ai)
#pragma unroll
            for (int m = 0; m < 4; ++m) {
                float* rowp = C + (size_t)(u.pm * 256 + ai * 128 + wr * 64 + m * 16 + fr) * ldc + u.pn * 256 + wc * 32 + 4 * fq;
#pragma unroll
                for (int bj = 0; bj < 2; ++bj)
#pragma unroll
                    for (int n = 0; n < 2; ++n) *(f32x4*)(rowp + bj * 128 + n * 16) = acc[ai][bj][m][n];
            }
    }
};
}

__device__ __forceinline__ void convert_matrix(const float* __restrict__ src, bf16_t* __restrict__ dst, int K, int N, int kind, const float* __restrict__ rowg, float rowmul,
                                               int tile0, int ntiles_total_before, int& item, int stride, LAS float* tile) {
    const int nTk = K / 64, nT = (N / 64) * nTk;
    const int tid = opaque_tid();
    while (item < ntiles_total_before + nT) {
        const int t = item - ntiles_total_before; const int tn = t / nTk, tk = t % nTk;
        {
            const int nl = tid & 63, kl0 = tid >> 6; const int ns = tn * 64 + nl;
            int no = ns; float cs = 1.f;
            if (kind == 0) {
                if (ns < 1024) { const int pp = ns & 63; no = (ns & ~63) + (pp & 1) * 32 + (pp >> 1); if (ns < 512) cs = 0.125f * LOG2E; }
                else if (ns >= 1536 && ns < 4608) { const int pp = ns & 127; no = (ns & ~127) + (pp & 1) * 64 + (pp >> 1); if (ns < 3072) cs = 0.08838834764831845f * LOG2E; }
            } else if (kind == 4) { no = (ns & 1) ? DFF + (ns >> 1) : (ns >> 1); }
#pragma unroll
            for (int i = 0; i < 8; ++i) { const int kl = kl0 + 8 * i, k = tk * 64 + kl;
                float v = src[(size_t)k * N + no] * cs;
                if (rowg) v *= rowg[(kind == 1) ? (k & 127) : k] * rowmul;
                tile[kl * 65 + nl] = v; }
        }
        __syncthreads();
        {
            const int kl = tid & 63, nl0 = tid >> 6;
#pragma unroll
            for (int i = 0; i < 8; ++i) { const int nl = nl0 + 8 * i;
                const unsigned pk = pack2(tile[kl * 65 + nl], 0.f);
                dst[(size_t)(tn * 64 + nl) * K + tk * 64 + kl] = (bf16_t)(pk & 0xffffu); }
        }
        __syncthreads();
        item += stride;
    }
    (void)tile0;
}

__device__ void convert_weights(const Params& p, int l, LAS unsigned char* lds) {
    LAS float* tile = (LAS float*)lds;
    unsigned char* ws = p.ws;
    int item = opaque_bid(); const int stride = gridDim.x; int before = 0;
    const float lam_init = 0.8f - 0.6f * __expf(-0.3f * (float)l);
    convert_matrix(p.w_in + (size_t)l * DM * INC, (bf16_t*)(ws + W_IN), DM, INC, 0, p.pre_mix_g + l * DM, 1.f, 0, before, item, stride, tile); before += (INC / 64) * (DM / 64);
    convert_matrix(p.w_a_out + (size_t)l * 512 * DM, (bf16_t*)(ws + W_A), 512, DM, 1, p.diff_head_g + l * 128, 1.f - lam_init, 0, before, item, stride, tile); before += (DM / 64) * (512 / 64);
    convert_matrix(p.w_b_out + (size_t)l * 512 * DM, (bf16_t*)(ws + W_B), 512, DM, 2, nullptr, 1.f, 0, before, item, stride, tile); before += (DM / 64) * (512 / 64);
    convert_matrix(p.w_mix_out + (size_t)l * DM * DM, (bf16_t*)(ws + W_MIX), DM, DM, 2, nullptr, 1.f, 0, before, item, stride, tile); before += (DM / 64) * (DM / 64);
    convert_matrix(p.w_up + (size_t)l * DM * UPC, (bf16_t*)(ws + W_UP), DM, UPC, 4, p.pre_ffn_g + l * DM, 1.f, 0, before, item, stride, tile); before += (UPC / 64) * (DM / 64);
    convert_matrix(p.w_down + (size_t)l * DFF * DM, (bf16_t*)(ws + W_DOWN), DFF, DM, 2, nullptr, 1.f, 0, before, item, stride, tile);
}

__device__ void rowpass(const float* __restrict__ xsrc, const float* __restrict__ add, const float* __restrict__ g, float* __restrict__ xdst, bf16_t* __restrict__ hb, int rows) {
    const int tid = opaque_tid(); const int lane = tid & 63, wv = tid >> 6;
    for (int r = opaque_bid() * 8 + wv; r < rows; r += gridDim.x * 8) {
        f32x4 xv[4];
#pragma unroll
        for (int i = 0; i < 4; ++i) xv[i] = *(const f32x4*)(xsrc + (size_t)r * DM + i * 256 + lane * 4);
        if (add) {
            f32x4 av[4]; float ss = 0.f;
#pragma unroll
            for (int i = 0; i < 4; ++i) { av[i] = *(const f32x4*)(add + (size_t)r * DM + i * 256 + lane * 4); ss += av[i][0] * av[i][0] + av[i][1] * av[i][1] + av[i][2] * av[i][2] + av[i][3] * av[i][3]; }
            ss = wave_sum(ss);
            const float rs = __builtin_amdgcn_rsqf(ss * (1.f / DM) + EPS);
#pragma unroll
            for (int i = 0; i < 4; ++i) { const f32x4 gv = *(const f32x4*)(g + i * 256 + lane * 4);
                xv[i] = xv[i] + av[i] * gv * rs;
                *(f32x4*)(xdst + (size_t)r * DM + i * 256 + lane * 4) = xv[i]; }
        }
        if (hb) {
            float ss = 0.f;
#pragma unroll
            for (int i = 0; i < 4; ++i) ss += xv[i][0] * xv[i][0] + xv[i][1] * xv[i][1] + xv[i][2] * xv[i][2] + xv[i][3] * xv[i][3];
            ss = wave_sum(ss);
            const float rs = __builtin_amdgcn_rsqf(ss * (1.f / DM) + EPS);
#pragma unroll
            for (int i = 0; i < 4; ++i) { u32x2 o = {pack2(xv[i][0] * rs, xv[i][1] * rs), pack2(xv[i][2] * rs, xv[i][3] * rs)};
                *(u32x2*)(hb + (size_t)r * DM + i * 256 + lane * 4) = o; }
        }
    }
}

struct AttnJob {
    const bf16_t* Q; const bf16_t* K; const bf16_t* V;
    int t0, dil, n, jt0, jt1, W;
    bf16_t* O; int ldo; float* lse; float lam;
};
constexpr int KSTR = 272, VSTR = 288, KBYTES = 64 * KSTR, VBYTES = 64 * VSTR, ABUF = KBYTES + VBYTES;

template <int NC>
__device__ __forceinline__ void attn_job(const AttnJob& J, LAS unsigned char* lds) {
    const int tid = opaque_tid(), lane = tid & 63, w = __builtin_amdgcn_readfirstlane(tid >> 6), li = lane & 15, g = lane >> 4;
    const int qidx = J.n * 128 + w * 16 + li;
    const size_t qtok = (size_t)J.t0 + (size_t)J.dil * qidx;
    bf16x8 qf[4];
    { const bf16_t* qp = J.Q + qtok * INC + 8 * g;
#pragma unroll
      for (int f = 0; f < 4; ++f) qf[f] = *(const bf16x8*)(qp + f * 32); }
    f32x4 oacc[NC][8];
#pragma unroll
    for (int c = 0; c < NC; ++c)
#pragma unroll
        for (int d = 0; d < 8; ++d) oacc[c][d] = (f32x4){0.f, 0.f, 0.f, 0.f};
    float mrun[NC], lrun[NC];
#pragma unroll
    for (int c = 0; c < NC; ++c) { mrun[c] = -INFINITY; lrun[c] = 0.f; }

    const int srow = tid >> 4, sch = tid & 15;
    u32x4 kst[2], vst[2];
    auto gload = [&](int j) {
#pragma unroll
        for (int i = 0; i < 2; ++i) { const size_t tok = (size_t)J.t0 + (size_t)J.dil * (64 * j + srow + 32 * i);
            kst[i] = *(const u32x4*)(J.K + tok * INC + sch * 8); vst[i] = *(const u32x4*)(J.V + tok * INC + sch * 8); }
    };
    auto lstore = [&](int b) {
#pragma unroll
        for (int i = 0; i < 2; ++i) { *(LAS u32x4*)(lds + b * ABUF + (srow + 32 * i) * KSTR + sch * 16) = kst[i];
            *(LAS u32x4*)(lds + b * ABUF + KBYTES + (srow + 32 * i) * VSTR + sch * 16) = vst[i]; }
    };
    gload(J.jt0); lstore(0);
    __syncthreads();
    const int qlo = J.n * 128 + w * 16, qhi = qlo + 15;
    for (int j = J.jt0; j < J.jt1; ++j) {
        const int cb = (j - J.jt0) & 1;
        const bool more = (j + 1 < J.jt1);
        if (more) gload(j + 1);
        const int relmax = qhi - 64 * j, relmin = qlo - (64 * j + 63);
        if (relmax >= 0 && relmin <= J.W) {
            const bool needmask = (relmin < 0) || (relmax > J.W);
            LAS unsigned char* kb_ = lds + cb * ABUF; LAS unsigned char* vb_ = kb_ + KBYTES;
            f32x4 sacc[NC][4];
#pragma unroll
            for (int c = 0; c < NC; ++c)
#pragma unroll
                for (int kb = 0; kb < 4; ++kb) sacc[c][kb] = (f32x4){0.f, 0.f, 0.f, 0.f};
#pragma unroll
            for (int kb = 0; kb < 4; ++kb)
#pragma unroll
                for (int f = 0; f < 4; ++f) {
                    const bf16x8 kf = *(const LAS bf16x8*)(kb_ + (kb * 16 + li) * KSTR + (f * 32 + 8 * g) * 2);
                    const int c = (NC == 2) ? (f >> 1) : 0;
                    sacc[c][kb] = __builtin_amdgcn_mfma_f32_16x16x32_bf16(kf, qf[f], sacc[c][kb], 0, 0, 0);
                }
            bf16x8 pf[NC][2];
#pragma unroll
            for (int c = 0; c < NC; ++c) {
                if (needmask) {
#pragma unroll
                    for (int kb = 0; kb < 4; ++kb)
#pragma unroll
                        for (int r = 0; r < 4; ++r) { const int rel = qidx - (64 * j + 16 * kb + 4 * g + r);
                            if (rel < 0 || rel > J.W) sacc[c][kb][r] = -INFINITY; }
                }
                float tm = -INFINITY;
#pragma unroll
                for (int kb = 0; kb < 4; ++kb)
#pragma unroll
                    for (int r = 0; r < 4; ++r) tm = fmaxf(tm, sacc[c][kb][r]);
                tm = fmaxf(tm, __shfl_xor(tm, 16)); tm = fmaxf(tm, __shfl_xor(tm, 32));
                const float mnew = fmaxf(mrun[c], tm);
                const float muse = (mnew == -INFINITY) ? 0.f : mnew;
                const float alpha = __builtin_amdgcn_exp2f(mrun[c] - muse);
                mrun[c] = mnew;
                float ps = 0.f;
                float pv[4][4];
#pragma unroll
                for (int kb = 0; kb < 4; ++kb)
#pragma unroll
                    for (int r = 0; r < 4; ++r) { pv[kb][r] = __builtin_amdgcn_exp2f(sacc[c][kb][r] - muse); ps += pv[kb][r]; }
                lrun[c] = lrun[c] * alpha + ps;
#pragma unroll
                for (int d = 0; d < 8; ++d) oacc[c][d] = oacc[c][d] * alpha;
#pragma unroll
                for (int kk = 0; kk < 2; ++kk) {
                    u32x4 pk = {pack2(pv[2 * kk][0], pv[2 * kk][1]), pack2(pv[2 * kk][2], pv[2 * kk][3]),
                                pack2(pv[2 * kk + 1][0], pv[2 * kk + 1][1]), pack2(pv[2 * kk + 1][2], pv[2 * kk + 1][3])};
                    pf[c][kk] = __builtin_bit_cast(bf16x8, pk);
                }
            }
#pragma unroll
            for (int kk = 0; kk < 2; ++kk)
#pragma unroll
                for (int d = 0; d < 8; ++d) {
                    LAS unsigned char* vp = vb_ + (kk * 32 + 4 * g + (li >> 2)) * VSTR + (li & 3) * 8 + d * 32;
                    const s16x4 lo = __builtin_amdgcn_ds_read_tr16_b64_v4i16((LAS s16x4*)vp);
                    const s16x4 hi = __builtin_amdgcn_ds_read_tr16_b64_v4i16((LAS s16x4*)(vp + 16 * VSTR));
                    const bf16x8 vf = {lo[0], lo[1], lo[2], lo[3], hi[0], hi[1], hi[2], hi[3]};
#pragma unroll
                    for (int c = 0; c < NC; ++c) oacc[c][d] = __builtin_amdgcn_mfma_f32_16x16x32_bf16(vf, pf[c][kk], oacc[c][d], 0, 0, 0);
                }
        }
        if (more) lstore(cb ^ 1);
        __syncthreads();
    }
    float linv[NC];
#pragma unroll
    for (int c = 0; c < NC; ++c) { float l = lrun[c]; l += __shfl_xor(l, 16); l += __shfl_xor(l, 32); lrun[c] = l; linv[c] = 1.f / l; }
    bf16_t* op = J.O + qtok * J.ldo + 4 * g;
    if (NC == 2) {
        float ss = 0.f;
#pragma unroll
        for (int d = 0; d < 8; ++d)
#pragma unroll
            for (int r = 0; r < 4; ++r) { const float v = oacc[0][d][r] * linv[0] - J.lam * oacc[NC - 1][d][r] * linv[NC - 1]; oacc[0][d][r] = v; ss += v * v; }
        ss += __shfl_xor(ss, 16); ss += __shfl_xor(ss, 32);
        const float rs = __builtin_amdgcn_rsqf(ss * (1.f / 128.f) + EPS);
#pragma unroll
        for (int d = 0; d < 8; ++d) { u32x2 o = {pack2(oacc[0][d][0] * rs, oacc[0][d][1] * rs), pack2(oacc[0][d][2] * rs, oacc[0][d][3] * rs)};
            *(u32x2*)(op + 16 * d) = o; }
    } else {
#pragma unroll
        for (int d = 0; d < 8; ++d) { u32x2 o = {pack2(oacc[0][d][0] * linv[0], oacc[0][d][1] * linv[0]), pack2(oacc[0][d][2] * linv[0], oacc[0][d][3] * linv[0])};
            *(u32x2*)(op + 16 * d) = o; }
        if (g == 0) J.lse[qtok * 4] = mrun[0] + __builtin_amdgcn_logf(lrun[0]);
    }
}

__device__ void attn_phase(const Params& p, int l, const bf16_t* proj, bf16_t* oab, bf16_t* og, float* lse, LAS unsigned char* lds) {
    const int nbl = p.Mc / SEQ;
    const int nA = nbl * 4 * 16, nB = nbl * 384;
    float lam;
    { const int lane = opaque_tid() & 63; const float* lv = p.diff_lambda + l * 256;
      const float s1 = wave_sum(lv[lane] * lv[64 + lane]), s2 = wave_sum(lv[128 + lane] * lv[192 + lane]);
      lam = __expf(s1) - __expf(s2) + (0.8f - 0.6f * __expf(-0.3f * (float)l)); }
    for (int it = opaque_bid(); it < nA + nB; it += gridDim.x) {
        if (it < nA) {
            const int bh = it >> 4, pi = it & 15, bl = bh >> 2, h = bh & 3;
            const bf16_t* base = proj + (size_t)bl * SEQ * INC;
            for (int pass = 0; pass < 2; ++pass) {
                AttnJob J; J.Q = base + h * 128; J.K = base + 512 + h * 128; J.V = base + 1024 + h * 128;
                J.t0 = 0; J.dil = 1; J.n = pass == 0 ? 31 - pi : pi; J.jt0 = 0; J.jt1 = 2 * J.n + 2; J.W = 1 << 30;
                J.O = oab + (size_t)bl * SEQ * DM + h * 128; J.ldo = DM; J.lse = nullptr; J.lam = lam;
                attn_job<2>(J, lds);
            }
        } else {
            const int id = it - nA; const int bl = id / 384, rem = id % 384, gi = rem >> 7, h = (rem & 127) >> 5, idx = rem & 31;
            const int dil = 1 << (2 * gi), r = idx & (dil - 1), nblk = idx >> (2 * gi);
            const bf16_t* base = proj + (size_t)bl * SEQ * INC;
            AttnJob J; J.Q = base + 1536 + gi * 512 + h * 128; J.K = base + 3072 + gi * 512 + h * 128; J.V = base + 4608 + gi * 512 + h * 128;
            J.t0 = r; J.dil = dil; J.n = nblk; J.jt0 = nblk == 0 ? 0 : 2 * nblk - 2; J.jt1 = 2 * nblk + 2; J.W = 128;
            J.O = og + ((size_t)gi * p.Mc + (size_t)bl * SEQ) * 512 + h * 128; J.ldo = 512; J.lse = lse + ((size_t)gi * p.Mc + (size_t)bl * SEQ) * 4 + h; J.lam = 0.f;
            attn_job<1>(J, lds);
        }
    }
}

__device__ void combine_phase(const Params& p, const bf16_t* og, const float* lse, bf16_t* oab) {
    const int tid = opaque_tid(); const int lane = tid & 63, wv = tid >> 6, h = lane >> 4;
    const size_t Mc = p.Mc;
    for (int r = opaque_bid() * 8 + wv; r < p.Mc; r += gridDim.x * 8) {
        const float l0 = lse[(size_t)r * 4 + h], l1 = lse[(Mc + r) * 4 + h], l2 = lse[(2 * Mc + r) * 4 + h];
        const float mx = fmaxf(l0, fmaxf(l1, l2));
        float w0 = __builtin_amdgcn_exp2f(l0 - mx), w1 = __builtin_amdgcn_exp2f(l1 - mx), w2 = __builtin_amdgcn_exp2f(l2 - mx);
        const float inv = 1.f / (w0 + w1 + w2); w0 *= inv; w1 *= inv; w2 *= inv;
        const u32x4 a = *(const u32x4*)(og + (size_t)r * 512 + lane * 8), b = *(const u32x4*)(og + (Mc + r) * 512 + lane * 8), c = *(const u32x4*)(og + (2 * Mc + r) * 512 + lane * 8);
        u32x4 o;
#pragma unroll
        for (int i = 0; i < 4; ++i) o[i] = pack2(w0 * bflo(a[i]) + w1 * bflo(b[i]) + w2 * bflo(c[i]), w0 * bfhi(a[i]) + w1 * bfhi(b[i]) + w2 * bfhi(c[i]));
        *(u32x4*)(oab + (size_t)r * DM + 512 + lane * 8) = o;
    }
}

__device__ __forceinline__ float gelu_tanh(float x) {
    const float t = 0.7978845608028654f * (x + 0.044715f * x * x * x);
    return x * __builtin_amdgcn_rcpf(1.f + __builtin_amdgcn_exp2f(-2.f * LOG2E * t));
}
__device__ void convglu_phase(const Params& p, int l, const bf16_t* u, bf16_t* a) {
    const int ncg = DFF / 4; const int nitems = (p.Mc / 16) * ncg;
    const float* cw = p.conv_w + (size_t)l * 3 * UPC; const float* cb = p.conv_b + (size_t)l * UPC;
    for (int item = opaque_bid() * 512 + opaque_tid(); item < nitems; item += gridDim.x * 512) {
        const int cg_ = item % ncg, tg = item / ncg; const int j0 = cg_ * 4, t0 = tg * 16;
        f32x4 wg[3], wv[3];
#pragma unroll
        for (int t = 0; t < 3; ++t) { wg[t] = *(const f32x4*)(cw + t * UPC + j0); wv[t] = *(const f32x4*)(cw + t * UPC + DFF + j0); }
        const f32x4 bg = *(const f32x4*)(cb + j0), bv = *(const f32x4*)(cb + DFF + j0);
        f32x4 g2 = {0.f, 0.f, 0.f, 0.f}, v2 = g2, g1 = g2, v1 = g2;
        if ((t0 & (SEQ - 1)) != 0) {
            const u32x4 r2 = *(const u32x4*)(u + (size_t)(t0 - 2) * UPC + 2 * j0), r1 = *(const u32x4*)(u + (size_t)(t0 - 1) * UPC + 2 * j0);
#pragma unroll
            for (int k = 0; k < 4; ++k) { g2[k] = bflo(r2[k]); v2[k] = bfhi(r2[k]); g1[k] = bflo(r1[k]); v1[k] = bfhi(r1[k]); }
        }
#pragma unroll 4
        for (int i = 0; i < 16; ++i) {
            const u32x4 rc = *(const u32x4*)(u + (size_t)(t0 + i) * UPC + 2 * j0);
            f32x4 g0, v0;
#pragma unroll
            for (int k = 0; k < 4; ++k) { g0[k] = bflo(rc[k]); v0[k] = bfhi(rc[k]); }
            const f32x4 cgv = wg[0] * g2 + wg[1] * g1 + wg[2] * g0 + bg;
            const f32x4 cvv = wv[0] * v2 + wv[1] * v1 + wv[2] * v0 + bv;
            u32x2 o = {pack2(gelu_tanh(cgv[0]) * cvv[0], gelu_tanh(cgv[1]) * cvv[1]), pack2(gelu_tanh(cgv[2]) * cvv[2], gelu_tanh(cgv[3]) * cvv[3])};
            *(u32x2*)(a + (size_t)(t0 + i) * DFF + j0) = o;
            g2 = g1; v2 = v1; g1 = g0; v1 = v0;
        }
    }
}

#define XB_TMO      128
#define XB_XCNT(j)  (256  + 64 * (j))
#define XB_XSUB(j)  (1280 + 64 * (j))
#define XB_XGEN(j)  (2304 + 64 * (j))
#define XB_TOP      3328
#define XB_TOPGEN   3392
#define XCD_BAR_WORDS 3456
#define XB_SPIN_CAP (1u << 22)
__device__ __forceinline__ unsigned xb_ld(unsigned* p)              { return __hip_atomic_load(p, __ATOMIC_RELAXED, __HIP_MEMORY_SCOPE_AGENT); }
__device__ __forceinline__ unsigned xb_add(unsigned* p, unsigned v) { return __hip_atomic_fetch_add(p, v, __ATOMIC_RELAXED, __HIP_MEMORY_SCOPE_AGENT); }
__device__ __forceinline__ unsigned xb_xcc_id() { return (unsigned)__builtin_amdgcn_s_getreg((3 << 11) | 20) & 0xFu; }
#define XB_SPIN(cond, bar) do { unsigned _sp = 0; while (cond) { __builtin_amdgcn_s_sleep(1); \
    if ((++_sp & 255u) == 0u) { if (xb_ld(&(bar)[XB_TMO])) break; if (_sp > XB_SPIN_CAP) { atomicAdd(&(bar)[XB_TMO], 1u); break; } } } } while (0)
struct XcdBarrier { unsigned* bar; unsigned x; volatile LAS unsigned* st; };
__device__ __forceinline__ XcdBarrier xcd_barrier_post(unsigned* bar, volatile LAS unsigned* st) {
    XcdBarrier b; b.bar = bar; b.x = xb_xcc_id(); b.st = st;
    if (threadIdx.x == 0) (void)xb_add(&bar[XB_XCNT(b.x)], 1u);
    return b;
}
__device__ __forceinline__ void xcd_barrier_complete(unsigned* bar, unsigned x, unsigned& nloc, unsigned& nx) {
    const unsigned G = gridDim.x * gridDim.y * gridDim.z;
    unsigned sum, cnt, mine, sp = 0u;
    for (;;) {
        sum = 0u; cnt = 0u; mine = 0u;
#pragma unroll
        for (unsigned j = 0; j < 16; ++j) { const unsigned c = xb_ld(&bar[XB_XCNT(j)]); sum += c; cnt += (c > 0u) ? 1u : 0u; mine = (j == x) ? c : mine; }
        if (sum == G) break;
        __builtin_amdgcn_s_sleep(1);
        if ((++sp & 255u) == 0u) { if (xb_ld(&bar[XB_TMO])) break; if (sp > XB_SPIN_CAP) { atomicAdd(&bar[XB_TMO], 1u); break; } }
    }
    nloc = mine > 0u ? mine : 1u; nx = cnt > 0u ? cnt : 1u;
}
__device__ __forceinline__ void xcd_barrier(const XcdBarrier& b) {
    asm volatile("s_waitcnt vmcnt(0)" ::: "memory");
    __syncthreads();
    if (threadIdx.x == 0) {
        unsigned* bar = b.bar;
        __builtin_amdgcn_s_waitcnt(0);
        unsigned nloc = b.st[0], nx = b.st[1];
        if (nloc == 0u) { xcd_barrier_complete(bar, b.x, nloc, nx); b.st[0] = nloc; b.st[1] = nx; }
        const unsigned old = xb_add(&bar[XB_XSUB(b.x)], 1u);
        const unsigned gen = old / nloc;
        if (old + 1u == (gen + 1u) * nloc) {
            __builtin_amdgcn_fence(__ATOMIC_RELEASE, "agent");
            asm volatile("s_waitcnt vmcnt(0)" ::: "memory");
            const unsigned og = xb_add(&bar[XB_TOP], 1u);
            const unsigned tg = og / nx;
            if (og + 1u == (tg + 1u) * nx) xb_add(&bar[XB_TOPGEN], 1u);
            else XB_SPIN(xb_ld(&bar[XB_TOPGEN]) == tg, bar);
            __builtin_amdgcn_fence(__ATOMIC_ACQUIRE, "agent");
            xb_add(&bar[XB_XGEN(b.x)], 1u);
            asm volatile("s_waitcnt vmcnt(0)" ::: "memory");
        } else {
            XB_SPIN(xb_ld(&bar[XB_XGEN(b.x)]) == gen, bar);
            __builtin_amdgcn_fence(__ATOMIC_ACQUIRE, "agent");
            asm volatile("s_waitcnt vmcnt(0)" ::: "memory");
        }
    }
    __syncthreads();
}

__device__ __forceinline__ void run_step(const Params& p, int step, LAS unsigned char* lds) {
    unsigned char* ws = p.ws;
    bf16_t* HB = (bf16_t*)(ws + WS_HB);
    const size_t Mc = p.Mc;
    unsigned char* R1 = ws + WS_CH; unsigned char* R2 = R1 + Mc * 16896; unsigned char* R3 = R2 + Mc * 2048; float* LSE = (float*)(R3 + Mc * 5120);
    bf16_t* proj = (bf16_t*)R1; bf16_t* ubuf = (bf16_t*)R1; bf16_t* abuf = (bf16_t*)(R1 + Mc * 11264);
    bf16_t* zbuf = (bf16_t*)R2; bf16_t* hb2 = (bf16_t*)R2;
    bf16_t* oab = (bf16_t*)R3; bf16_t* og = (bf16_t*)(R3 + Mc * 2048); float* mix = (float*)R3;
    if (step == 0) {
        if (!PH_EN(100)) return;
        rowpass(p.x_in, nullptr, nullptr, nullptr, HB, NTOK);
        convert_weights(p, 0, lds);
        return;
    }
    const int s1 = step - 1; const int ph = s1 % NPH; const int lc = s1 / NPH; const int c = lc % p.nchunk, l = lc / p.nchunk;
    const size_t row0 = (size_t)c * Mc;
    pg8::StaticOrder S;
    switch (ph) {
    case 0: if (PH_EN(0)) { pg8::Gemm g{HB + row0 * DM, (const bf16_t*)(ws + W_IN), (int)Mc, INC, DM, DM}; S.init((int)Mc, INC, gridDim.x, opaque_bid());
              pg8::EpiProj E{proj, p.pos + row0}; pg8::gemm_phase(lds, g, S, E); } break;
    case 1: if (PH_EN(1)) attn_phase(p, l, proj, oab, og, LSE, lds); break;
    case 2: if (PH_EN(2)) combine_phase(p, og, LSE, oab); break;
    case 3: if (PH_EN(3)) { pg8::Gemm g{oab, (const bf16_t*)(ws + W_A), (int)Mc, DM, 512, DM}; S.init((int)Mc, DM, gridDim.x, opaque_bid());
              pg8::EpiGate<0> E{zbuf, proj, 6144}; pg8::gemm_phase(lds, g, S, E); } break;
    case 4: if (PH_EN(4)) { pg8::Gemm g{oab + 512, (const bf16_t*)(ws + W_B), (int)Mc, DM, 512, DM}; S.init((int)Mc, DM, gridDim.x, opaque_bid());
              pg8::EpiGate<1> E{zbuf, proj, 7168}; pg8::gemm_phase(lds, g, S, E); } break;
    case 5: if (PH_EN(5)) { pg8::Gemm g{zbuf, (const bf16_t*)(ws + W_MIX), (int)Mc, DM, DM, DM}; S.init((int)Mc, DM, gridDim.x, opaque_bid());
              pg8::EpiF32 E{mix, DM}; pg8::gemm_phase(lds, g, S, E); } break;
    case 6: if (PH_EN(6)) rowpass((l == 0 ? p.x_in : p.out) + row0 * DM, mix, p.post_mix_g + l * DM, p.out + row0 * DM, hb2, (int)Mc); break;
    case 7: if (PH_EN(7)) { pg8::Gemm g{hb2, (const bf16_t*)(ws + W_UP), (int)Mc, UPC, DM, DM}; S.init((int)Mc, UPC, gridDim.x, opaque_bid());
              pg8::EpiBf16 E{ubuf, UPC}; pg8::gemm_phase(lds, g, S, E); } break;
    case 8: if (PH_EN(8)) convglu_phase(p, l, ubuf, abuf); break;
    case 9: if (PH_EN(9)) { pg8::Gemm g{abuf, (const bf16_t*)(ws + W_DOWN), (int)Mc, DM, DFF, DFF}; S.init((int)Mc, DM, gridDim.x, opaque_bid());
              pg8::EpiF32 E{mix, DM}; pg8::gemm_phase(lds, g, S, E); } break;
    case 10: if (PH_EN(10)) { rowpass(p.out + row0 * DM, mix, p.post_ffn_g + l * DM, p.out + row0 * DM, (l + 1 < DEPTH) ? HB + row0 * DM : nullptr, (int)Mc);
             if (c == p.nchunk - 1 && l + 1 < DEPTH) convert_weights(p, l + 1, lds); }
             break;
    }
}

template <bool COOP>
__global__ void __launch_bounds__(512, 2) mk_fwd(Params p) {
    extern __shared__ __attribute__((aligned(16))) unsigned char smem[];
    LAS unsigned char* lds = (LAS unsigned char*)smem;
    XcdBarrier bar;
    if (COOP) {
        volatile LAS unsigned* st = (volatile LAS unsigned*)(lds + LDS_MAIN);
        if (threadIdx.x == 0) { st[0] = 0u; st[1] = 0u; }
        __syncthreads();
        bar = xcd_barrier_post((unsigned*)(p.ws + WS_BAR), st);
    }
    for (int step = p.ph_lo; step < p.ph_hi; ++step) {
        run_step(p, step, lds);
        if (COOP && step + 1 < p.ph_hi) {
            if (step == p.ph_lo) cg::this_grid().sync();
            else xcd_barrier(bar);
        }
    }
}

extern "C" void kernel_launch(void* const* d_in, const int* in_sizes, int n_in, void* d_out, int out_size, void* d_ws, size_t ws_size, hipStream_t stream) {
    static int grid = 0; static int Mc = 0;
    if (grid == 0) {
        int dev = 0, cus = 0, per_cu = 0;
        hipGetDevice(&dev);
        hipDeviceGetAttribute(&cus, hipDeviceAttributeMultiprocessorCount, dev);
        hipFuncSetAttribute((const void*)mk_fwd<true>, hipFuncAttributeMaxDynamicSharedMemorySize, LDS_BYTES);
        hipFuncSetAttribute((const void*)mk_fwd<false>, hipFuncAttributeMaxDynamicSharedMemorySize, LDS_BYTES);
        hipOccupancyMaxActiveBlocksPerMultiprocessor(&per_cu, (const void*)mk_fwd<true>, 512, LDS_BYTES);
        if (per_cu < 1) per_cu = 1;
        grid = cus * per_cu;
        Mc = NTOK;
        while (Mc > SEQ && WS_CH + (size_t)Mc * PER_TOK > ws_size) Mc >>= 1;
        fprintf(stderr, "kernel_launch: cus %d per_cu %d grid %d Mc %d ws %zu\n", cus, per_cu, grid, Mc, ws_size);
    }
    Params p{};
    p.x_in = (const float*)d_in[0]; p.pos = (const int*)d_in[1]; p.pre_mix_g = (const float*)d_in[2]; p.w_in = (const float*)d_in[3];
    p.diff_lambda = (const float*)d_in[4]; p.diff_head_g = (const float*)d_in[5]; p.w_a_out = (const float*)d_in[6]; p.w_b_out = (const float*)d_in[7];
    p.w_mix_out = (const float*)d_in[8]; p.post_mix_g = (const float*)d_in[9]; p.pre_ffn_g = (const float*)d_in[10]; p.w_up = (const float*)d_in[11];
    p.conv_w = (const float*)d_in[12]; p.conv_b = (const float*)d_in[13]; p.w_down = (const float*)d_in[14]; p.post_ffn_g = (const float*)d_in[15];
    p.out = (float*)d_out; p.ws = (unsigned char*)d_ws; p.Mc = Mc; p.nchunk = NTOK / Mc;
    const int nsteps = 1 + DEPTH * p.nchunk * NPH;
#if MK_SINGLE
    p.ph_lo = 0; p.ph_hi = nsteps;
    if (hipMemsetAsync((char*)d_ws + WS_BAR, 0, WS_BAR_BYTES, stream) != hipSuccess) fprintf(stderr, "memset of barrier words failed\n");
    void* args[] = {&p};
    hipError_t e = hipLaunchCooperativeKernel((const void*)mk_fwd<true>, dim3(grid), dim3(512), args, LDS_BYTES, stream);
    if (e != hipSuccess) fprintf(stderr, "cooperative launch failed: %s (grid %d)\n", hipGetErrorString(e), grid);
#else
    for (int s = 0; s < nsteps; ++s) {
        p.ph_lo = s; p.ph_hi = s + 1;
        hipLaunchKernelGGL(mk_fwd<false>, dim3(grid), dim3(512), LDS_BYTES, stream, p);
    }
#endif
    (void)in_sizes; (void)n_in; (void)out_size;
}
```

```cpp
#include <hip/hip_runtime.h>
#include <hip/hip_cooperative_groups.h>
#include <cstdio>
#include <cstdint>
namespace cg = cooperative_groups;

#ifndef MK_SINGLE
#define MK_SINGLE 1
#endif

#ifndef MK_REP
#define MK_REP -1
#endif
#ifndef MK_ONLY
#define MK_ONLY -1
#endif
#define PH_EN(k) ((MK_ONLY) < 0 || (MK_ONLY) == (k))
#define LAS __attribute__((address_space(3)))
typedef unsigned short bf16_t;
typedef short bf16x8 __attribute__((ext_vector_type(8)));
typedef short s16x4 __attribute__((ext_vector_type(4)));
typedef float f32x4 __attribute__((ext_vector_type(4)));
typedef float f32x2 __attribute__((ext_vector_type(2)));
typedef unsigned u32x4 __attribute__((ext_vector_type(4)));
typedef unsigned u32x2 __attribute__((ext_vector_type(2)));
typedef __bf16 bf2_t __attribute__((ext_vector_type(2)));

constexpr int DM = 1024, NBATCH = 8, SEQ = 4096, DEPTH = 4, NTOK = NBATCH * SEQ, INC = 8192, DFF = 2816, UPC = 2 * DFF;
constexpr int PLD = INC + 64;
constexpr float EPS = 1e-6f;
constexpr float LOG2E = 1.4426950408889634f;
constexpr int NPH = 10;
constexpr int LDS_MAIN = 131072;
constexpr int LDS_BYTES = LDS_MAIN + 16;

constexpr size_t W_IN = 0, W_A = W_IN + (size_t)INC * DM * 2, W_B = W_A + (size_t)DM * 512 * 2, W_MIX = W_B + (size_t)DM * 512 * 2,
                 W_UP = W_MIX + (size_t)DM * DM * 2, W_DOWN = W_UP + (size_t)UPC * DM * 2, W_END = W_DOWN + (size_t)DM * DFF * 2;
constexpr size_t WS_BAR = (W_END + 255) & ~(size_t)255;
constexpr size_t WS_BAR_BYTES = 16384;
constexpr size_t WS_HB = WS_BAR + WS_BAR_BYTES;
constexpr size_t WS_CH = WS_HB + (size_t)NTOK * DM * 2;
constexpr size_t PER_TOK = 16896 + 2048 + 5120 + 48;

struct Params {
    const float* x_in; const int* pos; const float* pre_mix_g; const float* w_in; const float* diff_lambda; const float* diff_head_g;
    const float* w_a_out; const float* w_b_out; const float* w_mix_out; const float* post_mix_g; const float* pre_ffn_g;
    const float* w_up; const float* conv_w; const float* conv_b; const float* w_down; const float* post_ffn_g;
    float* out; unsigned char* ws;
    int Mc, nchunk, ph_lo, ph_hi;
};

__device__ __forceinline__ unsigned pack2(float a, float b) { f32x2 v = {a, b}; bf2_t r = __builtin_convertvector(v, bf2_t); return __builtin_bit_cast(unsigned, r); }
__device__ __forceinline__ float bflo(unsigned u) { return __uint_as_float(u << 16); }
__device__ __forceinline__ float bfhi(unsigned u) { return __uint_as_float(u & 0xffff0000u); }
__device__ __forceinline__ int opaque_tid() { int t = threadIdx.x; asm volatile("" : "+v"(t)); return t; }
__device__ __forceinline__ int opaque_bid() { int t = blockIdx.x; asm volatile("" : "+s"(t)); return t; }
__device__ __forceinline__ float wave_sum(float v) {
#pragma unroll
    for (int o = 32; o > 0; o >>= 1) v += __shfl_xor(v, o);
    return v;
}

namespace pg8 {
constexpr int BM = 256, BK = 64, HALF = 128, HTB = HALF * BK * 2, STAGE_BYTES = 8 * HTB, NXCD = 8, WGM = 8;
__device__ __forceinline__ int lds_byte(int r, int c) { const int st = (r >> 4) * 2 + (c >> 5), rr = r & 15, cc = c & 31, ob = rr * 64 + cc * 2; return st * 1024 + (ob ^ (((ob >> 9) & 1) << 5)); }
__device__ __forceinline__ void stage_rc(int b, int& R, int& C) { const int st = b / 1024, sb = b % 1024, swz = sb ^ (((sb >> 9) & 1) << 5); R = (st >> 1) * 16 + swz / 64; C = (st & 1) * 32 + (swz % 64) / 2; }
__device__ __forceinline__ int perm32(int rho) { const int n = rho >> 4, i = rho & 15; return 8 * (i >> 2) + 4 * n + (i & 3); }

struct Unit { int pm, pn; };
struct Gemm { const bf16_t* A; const bf16_t* Bt; int M, N, K, lda; };

struct StaticOrder {
    int nM, nN, nwg, G, c;
    __device__ void init(int M, int N, int G_, int c_) { nM = M / BM; nN = N / BM; nwg = nM * nN; G = G_; c = c_; }
    __device__ bool next(int i, Unit& u) const {
        const long L = (long)i * G + c; if (L >= nwg) return false;
        int wgid = (int)L; { const int q = nwg / NXCD, r = nwg % NXCD, xcd = wgid % NXCD, off = wgid / NXCD; wgid = (xcd < r ? xcd * (q + 1) : r * (q + 1) + (xcd - r) * q) + off; }
        const int nig = WGM * nN, gid = wgid / nig, fm = gid * WGM, gsz = (nM - fm) < WGM ? (nM - fm) : WGM;
        u.pm = fm + ((wgid % nig) % gsz); u.pn = (wgid % nig) / gsz; return true;
    }
};

template <class Epi>
__device__ __forceinline__ void gemm_phase(LAS unsigned char* lds, const Gemm g, const StaticOrder& S, const Epi& E) {
    const int tid = opaque_tid(), wid = __builtin_amdgcn_readfirstlane(tid >> 6), lane = tid & 63, wr = wid >> 2, wc = wid & 3, fr = lane & 15, fq = lane >> 4;
    const int K = g.K, nt = K / BK, lda = g.lda;
    unsigned voffA[2], voffB[2];
#pragma unroll
    for (int i = 0; i < 2; ++i) { int R, C; stage_rc(tid * 16 + i * 8192, R, C); const int Rb = Epi::PERM ? ((R & ~31) + perm32(R & 31)) : R;
        const int Ra = Epi::ROWPERM ? ((R & ~63) + 4 * (R & 15) + ((R >> 4) & 3)) : R;
        voffA[i] = (unsigned)(Ra * lda + C) * 2u; voffB[i] = (unsigned)(Rb * K + C) * 2u; }
    const size_t kstep = (size_t)(BK * 2);
    const size_t hstepA = (size_t)HALF * lda * 2, hstepB = (size_t)HALF * K * 2;
    const size_t tstepA = 2 * hstepA, tstepB = 2 * hstepB;
    const unsigned ldsw = (unsigned)wid * 1024u;
    const int aoff = lds_byte(wr * 64 + fr, fq * 8), boff = lds_byte(wc * 32 + fr, fq * 8);
#define PG8_SA(b, h) (((b) * 2 + (h)) * HTB)
#define PG8_SB(b, h) ((4 + (b) * 2 + (h)) * HTB)
#define PG8_STAGE(bufoff, gbase, voff) do { _Pragma("unroll") for (int _i = 0; _i < 2; ++_i) \
        __builtin_amdgcn_global_load_lds((const unsigned*)((const char*)(gbase) + (voff)[_i]), (LAS unsigned*)(lds + (bufoff) + ldsw + _i * 8192), 16, 0, 0); } while (0)
#define PG8_LDA(dst, b, h) do { _Pragma("unroll") for (int m = 0; m < 4; ++m) _Pragma("unroll") for (int k = 0; k < 2; ++k) dst[m][k] = *(const LAS bf16x8*)(lds + PG8_SA(b, h) + aoff + m * 2048 + k * 1024); } while (0)
#define PG8_LDB(dst, b, h) do { _Pragma("unroll") for (int n = 0; n < 2; ++n) _Pragma("unroll") for (int k = 0; k < 2; ++k) dst[n][k] = *(const LAS bf16x8*)(lds + PG8_SB(b, h) + boff + n * 2048 + k * 1024); } while (0)
#define PG8_MMA(ai, bj, At, Bt) do { __builtin_amdgcn_s_setprio(1); _Pragma("unroll") for (int m = 0; m < 4; ++m) _Pragma("unroll") for (int n = 0; n < 2; ++n) _Pragma("unroll") for (int k = 0; k < 2; ++k) \
        acc[ai][bj][m][n] = __builtin_amdgcn_mfma_f32_16x16x32_bf16(Bt[n][k], At[m][k], acc[ai][bj][m][n], 0, 0, 0); __builtin_amdgcn_s_setprio(0); } while (0)
#define PG8_WAIT_V(n) asm volatile("s_waitcnt vmcnt(" #n ")" ::: "memory")
#define PG8_WAIT_L(n) asm volatile("s_waitcnt lgkmcnt(" #n ")" ::: "memory")
#define PG8_BAR __builtin_amdgcn_s_barrier()
#define PG8_SCHED __builtin_amdgcn_sched_barrier(0)
    Unit cur, nxt; int ui = 0;
    if (!S.next(0, cur)) return;
    f32x4 acc[2][2][4][2];
#pragma unroll
    for (int a = 0; a < 2; ++a)
#pragma unroll
        for (int b = 0; b < 2; ++b)
#pragma unroll
            for (int m = 0; m < 4; ++m)
#pragma unroll
                for (int n = 0; n < 2; ++n) acc[a][b][m][n] = (f32x4){0.f, 0.f, 0.f, 0.f};
    bf16x8 At[4][2], B0[2][2], B1[2][2];
    const char* cA = (const char*)g.A + (size_t)cur.pm * tstepA; const char* cB = (const char*)g.Bt + (size_t)cur.pn * tstepB;
    PG8_STAGE(PG8_SB(0, 0), cB, voffB); PG8_STAGE(PG8_SA(0, 0), cA, voffA); PG8_STAGE(PG8_SB(0, 1), cB + hstepB, voffB); PG8_STAGE(PG8_SA(0, 1), cA + hstepA, voffA);
    if (wr == 1) PG8_BAR;
    PG8_WAIT_V(4); PG8_BAR;
    PG8_STAGE(PG8_SB(1, 0), cB + kstep, voffB); PG8_STAGE(PG8_SA(1, 0), cA + kstep, voffA); PG8_STAGE(PG8_SB(1, 1), cB + hstepB + kstep, voffB);
    PG8_WAIT_V(6); PG8_BAR;
    for (;;) {
        const bool has_next = S.next(ui + 1, nxt);
        const char* nA = has_next ? (const char*)g.A + (size_t)nxt.pm * tstepA : cA; const char* nB = has_next ? (const char*)g.Bt + (size_t)nxt.pn * tstepB : cB;
        for (int t = 0; t < nt; t += 2) {
            const bool last = (t == nt - 2);
            const char* a1 = cA + (size_t)(t + 1) * kstep;
            const char* a2 = last ? nA : cA + (size_t)(t + 2) * kstep; const char* b2 = last ? nB : cB + (size_t)(t + 2) * kstep;
            const char* a3 = a2 + kstep; const char* b3 = b2 + kstep;
            PG8_LDB(B0, 0, 0); PG8_SCHED; PG8_LDA(At, 0, 0); PG8_STAGE(PG8_SA(1, 1), a1 + hstepA, voffA);
            PG8_WAIT_L(8); PG8_BAR; PG8_WAIT_L(0); PG8_MMA(0, 0, At, B0); PG8_BAR; PG8_SCHED;
            PG8_LDB(B1, 0, 1); PG8_STAGE(PG8_SB(0, 0), b2, voffB);
            PG8_BAR; PG8_WAIT_L(0); PG8_MMA(0, 1, At, B1); PG8_BAR;
            PG8_LDA(At, 0, 1); PG8_STAGE(PG8_SA(0, 0), a2, voffA);
            PG8_BAR; PG8_WAIT_L(0); PG8_MMA(1, 0, At, B0); PG8_BAR; PG8_SCHED;
            PG8_STAGE(PG8_SB(0, 1), b2 + hstepB, voffB);
            PG8_WAIT_V(6); PG8_BAR; PG8_MMA(1, 1, At, B1); PG8_BAR;
            PG8_LDB(B0, 1, 0); PG8_SCHED; PG8_LDA(At, 1, 0); PG8_STAGE(PG8_SA(0, 1), a2 + hstepA, voffA);
            PG8_WAIT_L(8); PG8_BAR; PG8_WAIT_L(0); PG8_MMA(0, 0, At, B0); PG8_BAR; PG8_SCHED;
            PG8_LDB(B1, 1, 1); PG8_STAGE(PG8_SB(1, 0), b3, voffB);
            PG8_BAR; PG8_WAIT_L(0); PG8_MMA(0, 1, At, B1); PG8_BAR;
            PG8_LDA(At, 1, 1); PG8_STAGE(PG8_SA(1, 0), a3, voffA);
            PG8_BAR; PG8_WAIT_L(0); PG8_MMA(1, 0, At, B0); PG8_BAR; PG8_SCHED;
            PG8_STAGE(PG8_SB(1, 1), b3 + hstepB, voffB);
            PG8_WAIT_V(6); PG8_BAR; PG8_MMA(1, 1, At, B1); PG8_BAR;
        }
        E(acc, cur, wr, wc, fr, fq);
        if (!has_next) break;
#pragma unroll
        for (int a = 0; a < 2; ++a)
#pragma unroll
            for (int b = 0; b < 2; ++b)
#pragma unroll
                for (int m = 0; m < 4; ++m)
#pragma unroll
                    for (int n = 0; n < 2; ++n) acc[a][b][m][n] = (f32x4){0.f, 0.f, 0.f, 0.f};
        cur = nxt; cA = nA; cB = nB; ++ui;
    }
    PG8_WAIT_V(0);
    if (wr == 0) PG8_BAR;
    PG8_BAR;
#undef PG8_SA
#undef PG8_SB
#undef PG8_STAGE
#undef PG8_LDA
#undef PG8_LDB
#undef PG8_MMA
#undef PG8_WAIT_V
#undef PG8_WAIT_L
#undef PG8_BAR
#undef PG8_SCHED
}

struct EpiProj {
    static constexpr bool PERM = true, ROWPERM = false;
    bf16_t* O; const int* pos;
    __device__ __forceinline__ void operator()(const f32x4 (&acc)[2][2][4][2], const Unit& u, int wr, int wc, int fr, int fq) const {
        const int pn = u.pn;
        int type;
        if (pn < 4) type = 1; else if (pn < 6) type = 0; else if (pn < 18) type = 2; else if (pn < 24) type = 0; else type = 3;
        float inv[2][4];
#pragma unroll
        for (int bj = 0; bj < 2; ++bj)
#pragma unroll
            for (int i = 0; i < 4; ++i) inv[bj][i] = 0.f;
        if (type == 1 || type == 2) {
            const int dim = type == 1 ? 64 : 128;
            const float c1 = (type == 1 ? (2.f / 64.f) : (2.f / 128.f)) * 13.287712379549449f;
#pragma unroll
            for (int bj = 0; bj < 2; ++bj) {
                const int col = pn * 256 + bj * 128 + wc * 32 + 8 * fq; const int jf0 = (col & (dim - 1)) >> 1;
#pragma unroll
                for (int i = 0; i < 4; ++i) inv[bj][i] = __builtin_amdgcn_exp2f(-(float)(jf0 + i) * c1 - 2.651496129472319f);
            }
        }
#pragma unroll
        for (int ai = 0; ai < 2; ++ai)
#pragma unroll
            for (int m = 0; m < 4; ++m) {
                const int row = u.pm * 256 + ai * 128 + wr * 64 + m * 16 + fr;
                const float posf = (float)pos[row];
#pragma unroll
                for (int bj = 0; bj < 2; ++bj) {
                    const int col = pn * 256 + bj * 128 + wc * 32 + 8 * fq;
                    f32x4 v0 = acc[ai][bj][m][0], v1 = acc[ai][bj][m][1];
                    float v[8] = {v0[0], v0[1], v0[2], v0[3], v1[0], v1[1], v1[2], v1[3]};
                    if (type == 1 || type == 2) {
#pragma unroll
                        for (int i = 0; i < 4; ++i) {
                            float rev = posf * inv[bj][i]; rev -= __builtin_rintf(rev);
                            const float sn = __builtin_amdgcn_sinf(rev), cs = __builtin_amdgcn_cosf(rev);
                            const float x1 = v[2 * i], x2 = v[2 * i + 1];
                            v[2 * i] = x1 * cs - x2 * sn; v[2 * i + 1] = x2 * cs + x1 * sn;
                        }
                    } else if (type == 3) {
#pragma unroll
                        for (int i = 0; i < 8; ++i) v[i] = __builtin_amdgcn_rcpf(1.f + __builtin_amdgcn_exp2f(-v[i] * LOG2E));
                    }
                    u32x4 o = {pack2(v[0], v[1]), pack2(v[2], v[3]), pack2(v[4], v[5]), pack2(v[6], v[7])};
                    *(u32x4*)(O + (size_t)row * PLD + col) = o;
                }
            }
    }
};
struct EpiBf16 {
    static constexpr bool PERM = true, ROWPERM = false;
    bf16_t* O; int ldc;
    __device__ __forceinline__ void operator()(const f32x4 (&acc)[2][2][4][2], const Unit& u, int wr, int wc, int fr, int fq) const {
#pragma unroll
        for (int ai = 0; ai < 2; ++ai)
#pragma unroll
            for (int m = 0; m < 4; ++m) {
                const int row = u.pm * 256 + ai * 128 + wr * 64 + m * 16 + fr;
#pragma unroll
                for (int bj = 0; bj < 2; ++bj) {
                    const int col = u.pn * 256 + bj * 128 + wc * 32 + 8 * fq;
                    f32x4 v0 = acc[ai][bj][m][0], v1 = acc[ai][bj][m][1];
                    u32x4 o = {pack2(v0[0], v0[1]), pack2(v0[2], v0[3]), pack2(v1[0], v1[1]), pack2(v1[2], v1[3])};
                    *(u32x4*)(O + (size_t)row * ldc + col) = o;
                }
            }
    }
};
template <int MODE> struct EpiGate {
    static constexpr bool PERM = true, ROWPERM = false;
    bf16_t* Z; const bf16_t* P; int goff;
    __device__ __forceinline__ void operator()(const f32x4 (&acc)[2][2][4][2], const Unit& u, int wr, int wc, int fr, int fq) const {
#pragma unroll
        for (int ai = 0; ai < 2; ++ai)
#pragma unroll
            for (int m = 0; m < 4; ++m) {
                const int row = u.pm * 256 + ai * 128 + wr * 64 + m * 16 + fr;
#pragma unroll
                for (int bj = 0; bj < 2; ++bj) {
                    const int col = u.pn * 256 + bj * 128 + wc * 32 + 8 * fq;
                    f32x4 v0 = acc[ai][bj][m][0], v1 = acc[ai][bj][m][1];
                    const u32x4 gt = *(const u32x4*)(P + (size_t)row * PLD + goff + col);
                    float r[8] = {v0[0] * bflo(gt[0]), v0[1] * bfhi(gt[0]), v0[2] * bflo(gt[1]), v0[3] * bfhi(gt[1]),
                                  v1[0] * bflo(gt[2]), v1[1] * bfhi(gt[2]), v1[2] * bflo(gt[3]), v1[3] * bfhi(gt[3])};
                    u32x4* zp = (u32x4*)(Z + (size_t)row * DM + col);
                    if (MODE == 1) { const u32x4 zo = *zp;
                        r[0] += bflo(zo[0]); r[1] += bfhi(zo[0]); r[2] += bflo(zo[1]); r[3] += bfhi(zo[1]);
                        r[4] += bflo(zo[2]); r[5] += bfhi(zo[2]); r[6] += bflo(zo[3]); r[7] += bfhi(zo[3]); }
                    u32x4 o = {pack2(r[0], r[1]), pack2(r[2], r[3]), pack2(r[4], r[5]), pack2(r[6], r[7])};
                    *zp = o;
                }
            }
    }
};
struct EpiF32 {
    static constexpr bool PERM = false, ROWPERM = false;
    float* C; int ldc;
    __device__ __forceinline__ void operator()(const f32x4 (&acc)[2][2][4][2], const Unit& u, int wr, int wc, int fr, int fq) const {
#pragma unroll
        for (int ai = 0; ai < 2; ++ai)
#pragma unroll
            for (int m = 0; m < 4; ++m) {
                float* rowp = C + (size_t)(u.pm * 256 + ai * 128 + wr * 64 + m * 16 + fr) * ldc + u.pn * 256 + wc * 32 + 4 * fq;
#pragma unroll
                for (int bj = 0; bj < 2; ++bj)
#pragma unroll
                    for (int n = 0; n < 2; ++n) *(f32x4*)(rowp + bj * 128 + n * 16) = acc[ai][bj][m][n];
            }
    }
};

__device__ __forceinline__ float gelu_tanh_e(float x) {
    const float t = 0.7978845608028654f * (x + 0.044715f * x * x * x);
    return x * __builtin_amdgcn_rcpf(1.f + __builtin_amdgcn_exp2f(-2.f * LOG2E * t));
}
__device__ __forceinline__ float dpp_shr1(float v) { return __builtin_bit_cast(float, __builtin_amdgcn_update_dpp(0, __builtin_bit_cast(int, v), 0x111, 0xf, 0xf, true)); }
struct EpiConvGlu {
    static constexpr bool PERM = true, ROWPERM = true;
    bf16_t* Aout; bf16_t* edge; const float* cw; const float* cb;
    __device__ __forceinline__ void operator()(const f32x4 (&acc)[2][2][4][2], const Unit& u, int wr, int wc, int fr, int fq) const {
#pragma unroll
        for (int bj = 0; bj < 2; ++bj) {
            const int col = u.pn * 256 + bj * 128 + wc * 32 + 8 * fq;
            const int ch = col >> 1;
            f32x4 wg[3], wv[3];
#pragma unroll
            for (int t = 0; t < 3; ++t) { wg[t] = *(const f32x4*)(cw + t * UPC + ch); wv[t] = *(const f32x4*)(cw + t * UPC + DFF + ch); }
            const f32x4 bg = *(const f32x4*)(cb + ch), bv = *(const f32x4*)(cb + DFF + ch);
#pragma unroll
            for (int ai = 0; ai < 2; ++ai) {
                const int tok0 = u.pm * 256 + ai * 128 + wr * 64;
                f32x4 G[4], V[4];
#pragma unroll
                for (int m = 0; m < 4; ++m) { const f32x4 a0 = acc[ai][bj][m][0], a1 = acc[ai][bj][m][1];
                    G[m] = (f32x4){a0[0], a0[2], a1[0], a1[2]}; V[m] = (f32x4){a0[1], a0[3], a1[1], a1[3]}; }
                f32x4 Gp3, Gp2, Vp3, Vp2;
#pragma unroll
                for (int k = 0; k < 4; ++k) { Gp3[k] = dpp_shr1(G[3][k]); Gp2[k] = dpp_shr1(G[2][k]); Vp3[k] = dpp_shr1(V[3][k]); Vp2[k] = dpp_shr1(V[2][k]); }
                bf16_t* eb = edge + (size_t)(tok0 >> 6) * 4 * UPC + col;
                if (fr == 0) {
#pragma unroll
                    for (int m = 0; m < 2; ++m) { u32x4 o = {pack2(G[m][0], V[m][0]), pack2(G[m][1], V[m][1]), pack2(G[m][2], V[m][2]), pack2(G[m][3], V[m][3])}; *(u32x4*)(eb + (size_t)m * UPC) = o; }
                }
                if (fr == 15) {
#pragma unroll
                    for (int m = 2; m < 4; ++m) { u32x4 o = {pack2(G[m][0], V[m][0]), pack2(G[m][1], V[m][1]), pack2(G[m][2], V[m][2]), pack2(G[m][3], V[m][3])}; *(u32x4*)(eb + (size_t)m * UPC) = o; }
                }
#pragma unroll
                for (int m = 0; m < 4; ++m) {
                    const f32x4 g1 = (m >= 1) ? G[m >= 1 ? m - 1 : 0] : Gp3, g2 = (m >= 2) ? G[m >= 2 ? m - 2 : 0] : (m == 1 ? Gp3 : Gp2);
                    const f32x4 v1 = (m >= 1) ? V[m >= 1 ? m - 1 : 0] : Vp3, v2 = (m >= 2) ? V[m >= 2 ? m - 2 : 0] : (m == 1 ? Vp3 : Vp2);
                    const f32x4 cg_ = wg[0] * g2 + wg[1] * g1 + wg[2] * G[m] + bg;
                    const f32x4 cv_ = wv[0] * v2 + wv[1] * v1 + wv[2] * V[m] + bv;
                    u32x2 o = {pack2(gelu_tanh_e(cg_[0]) * cv_[0], gelu_tanh_e(cg_[1]) * cv_[1]), pack2(gelu_tanh_e(cg_[2]) * cv_[2], gelu_tanh_e(cg_[3]) * cv_[3])};
                    *(u32x2*)(Aout + (size_t)(tok0 + 4 * fr + m) * DFF + ch) = o;
                }
            }
        }
    }
};
}

__device__ __forceinline__ void convert_matrix(const float* __restrict__ src, bf16_t* __restrict__ dst, int K, int N, int kind, const float* __restrict__ rowg, float rowmul,
                                               int tile0, int ntiles_total_before, int& item, int stride, LAS float* tile) {
    const int nTk = K / 64, nT = (N / 64) * nTk;
    const int tid = opaque_tid();
    while (item < ntiles_total_before + nT) {
        const int t = item - ntiles_total_before; const int tn = t / nTk, tk = t % nTk;
        {
            const int nl = tid & 63, kl0 = tid >> 6; const int ns = tn * 64 + nl;
            int no = ns; float cs = 1.f;
            if (kind == 0) {
                if (ns < 1024) { const int pp = ns & 63; no = (ns & ~63) + (pp & 1) * 32 + (pp >> 1); if (ns < 512) cs = 0.125f * LOG2E; }
                else if (ns >= 1536 && ns < 4608) { const int pp = ns & 127; no = (ns & ~127) + (pp & 1) * 64 + (pp >> 1); if (ns < 3072) cs = 0.08838834764831845f * LOG2E; }
            } else if (kind == 4) { no = (ns & 1) ? DFF + (ns >> 1) : (ns >> 1); }
#pragma unroll
            for (int i = 0; i < 8; ++i) { const int kl = kl0 + 8 * i, k = tk * 64 + kl;
                float v = src[(size_t)k * N + no] * cs;
                if (rowg) v *= rowg[(kind == 1) ? (k & 127) : k] * rowmul;
                tile[kl * 65 + nl] = v; }
        }
        __syncthreads();
        {
            const int kl = tid & 63, nl0 = tid >> 6;
#pragma unroll
            for (int i = 0; i < 8; ++i) { const int nl = nl0 + 8 * i;
                const unsigned pk = pack2(tile[kl * 65 + nl], 0.f);
                dst[(size_t)(tn * 64 + nl) * K + tk * 64 + kl] = (bf16_t)(pk & 0xffffu); }
        }
        __syncthreads();
        item += stride;
    }
    (void)tile0;
}

__device__ void convert_weights(const Params& p, int l, LAS unsigned char* lds) {
    LAS float* tile = (LAS float*)lds;
    unsigned char* ws = p.ws;
    int item = opaque_bid(); const int stride = gridDim.x; int before = 0;
    const float lam_init = 0.8f - 0.6f * __expf(-0.3f * (float)l);
    convert_matrix(p.w_in + (size_t)l * DM * INC, (bf16_t*)(ws + W_IN), DM, INC, 0, p.pre_mix_g + l * DM, 1.f, 0, before, item, stride, tile); before += (INC / 64) * (DM / 64);
    convert_matrix(p.w_a_out + (size_t)l * 512 * DM, (bf16_t*)(ws + W_A), 512, DM, 1, p.diff_head_g + l * 128, 1.f - lam_init, 0, before, item, stride, tile); before += (DM / 64) * (512 / 64);
    convert_matrix(p.w_b_out + (size_t)l * 512 * DM, (bf16_t*)(ws + W_B), 512, DM, 2, nullptr, 1.f, 0, before, item, stride, tile); before += (DM / 64) * (512 / 64);
    convert_matrix(p.w_mix_out + (size_t)l * DM * DM, (bf16_t*)(ws + W_MIX), DM, DM, 2, nullptr, 1.f, 0, before, item, stride, tile); before += (DM / 64) * (DM / 64);
    convert_matrix(p.w_up + (size_t)l * DM * UPC, (bf16_t*)(ws + W_UP), DM, UPC, 4, p.pre_ffn_g + l * DM, 1.f, 0, before, item, stride, tile); before += (UPC / 64) * (DM / 64);
    convert_matrix(p.w_down + (size_t)l * DFF * DM, (bf16_t*)(ws + W_DOWN), DFF, DM, 2, nullptr, 1.f, 0, before, item, stride, tile);
}

__device__ void rowpass(const float* __restrict__ xsrc, const bf16_t* __restrict__ add, const float* __restrict__ g, float* __restrict__ xdst, bf16_t* __restrict__ hb, int rows) {
    const int tid = opaque_tid(); const int lane = tid & 63, wv = tid >> 6;
    constexpr int NR = 2;
    const int rstride = gridDim.x * 8;
    for (int r0 = opaque_bid() * 8 + wv; r0 < rows; r0 += rstride * NR) {
        f32x4 xv[NR][4]; u32x2 avr[NR][4];
#pragma unroll
        for (int q = 0; q < NR; ++q) { const int r = r0 + q * rstride;
            if (r < rows) {
#pragma unroll
                for (int i = 0; i < 4; ++i) xv[q][i] = *(const f32x4*)(xsrc + (size_t)r * DM + i * 256 + lane * 4);
                if (add) {
#pragma unroll
                    for (int i = 0; i < 4; ++i) avr[q][i] = *(const u32x2*)(add + (size_t)r * DM + i * 256 + lane * 4);
                }
            } }
#pragma unroll
        for (int q = 0; q < NR; ++q) { const int r = r0 + q * rstride;
            if (r < rows) {
                if (add) {
                    f32x4 av[1][4];
#pragma unroll
                    for (int i = 0; i < 4; ++i) av[0][i] = (f32x4){bflo(avr[q][i][0]), bfhi(avr[q][i][0]), bflo(avr[q][i][1]), bfhi(avr[q][i][1])};
                    float ss = 0.f;
#pragma unroll
                    for (int i = 0; i < 4; ++i) ss += av[0][i][0] * av[0][i][0] + av[0][i][1] * av[0][i][1] + av[0][i][2] * av[0][i][2] + av[0][i][3] * av[0][i][3];
                    ss = wave_sum(ss);
                    const float rs = __builtin_amdgcn_rsqf(ss * (1.f / DM) + EPS);
#pragma unroll
                    for (int i = 0; i < 4; ++i) { const f32x4 gv = *(const f32x4*)(g + i * 256 + lane * 4);
                        xv[q][i] = xv[q][i] + av[0][i] * gv * rs;
                        *(f32x4*)(xdst + (size_t)r * DM + i * 256 + lane * 4) = xv[q][i]; }
                }
                if (hb) {
                    float ss = 0.f;
#pragma unroll
                    for (int i = 0; i < 4; ++i) ss += xv[q][i][0] * xv[q][i][0] + xv[q][i][1] * xv[q][i][1] + xv[q][i][2] * xv[q][i][2] + xv[q][i][3] * xv[q][i][3];
                    ss = wave_sum(ss);
                    const float rs = __builtin_amdgcn_rsqf(ss * (1.f / DM) + EPS);
#pragma unroll
                    for (int i = 0; i < 4; ++i) { u32x2 o = {pack2(xv[q][i][0] * rs, xv[q][i][1] * rs), pack2(xv[q][i][2] * rs, xv[q][i][3] * rs)};
                        *(u32x2*)(hb + (size_t)r * DM + i * 256 + lane * 4) = o; }
                }
            } }
    }
}

struct AttnJob {
    const bf16_t* Q; const bf16_t* K; const bf16_t* V;
    int t0, dil, n, jt0, jt1, W;
    bf16_t* O; int ldo; float* lse; float lam;
};
constexpr int KSTR = 272, VSTR = 288, KBYTES = 64 * KSTR, VBYTES = 64 * VSTR, ABUF = KBYTES + VBYTES;

template <int NC>
__device__ __forceinline__ void attn_job(const AttnJob& J, LAS unsigned char* lds) {
    const int tid = opaque_tid(), lane = tid & 63, w = __builtin_amdgcn_readfirstlane(tid >> 6), li = lane & 15, g = lane >> 4;
    const int qidx = J.n * 128 + w * 16 + li;
    const size_t qtok = (size_t)J.t0 + (size_t)J.dil * qidx;
    bf16x8 qf[4];
    { const bf16_t* qp = J.Q + qtok * PLD + 8 * g;
#pragma unroll
      for (int f = 0; f < 4; ++f) qf[f] = *(const bf16x8*)(qp + f * 32); }
    f32x4 oacc[NC][8], lacc[NC];
#pragma unroll
    for (int c = 0; c < NC; ++c) { lacc[c] = (f32x4){0.f, 0.f, 0.f, 0.f};
#pragma unroll
        for (int d = 0; d < 8; ++d) oacc[c][d] = (f32x4){0.f, 0.f, 0.f, 0.f}; }
    float mref[NC];
#pragma unroll
    for (int c = 0; c < NC; ++c) mref[c] = 0.f;
    bool first = true;
    const bf16x8 ones = {16256, 16256, 16256, 16256, 16256, 16256, 16256, 16256};

    const int srow = tid >> 4, sch = tid & 15;
    u32x4 kst[2], vst[2];
    auto gload = [&](int j) {
#pragma unroll
        for (int i = 0; i < 2; ++i) { const size_t tok = (size_t)J.t0 + (size_t)J.dil * (64 * j + srow + 32 * i);
            kst[i] = *(const u32x4*)(J.K + tok * PLD + sch * 8); vst[i] = *(const u32x4*)(J.V + tok * PLD + sch * 8); }
    };
    auto lstore = [&](int b) {
#pragma unroll
        for (int i = 0; i < 2; ++i) { *(LAS u32x4*)(lds + b * ABUF + (srow + 32 * i) * KSTR + sch * 16) = kst[i];
            *(LAS u32x4*)(lds + b * ABUF + KBYTES + (srow + 32 * i) * VSTR + sch * 16) = vst[i]; }
    };
    const int ntile = J.jt1 - J.jt0;
    gload(J.jt1 - 1); lstore(0);
    __syncthreads();
    const int qlo = J.n * 128 + w * 16, qhi = qlo + 15;
    for (int jj = 0; jj < ntile; ++jj) {
        const int j = J.jt1 - 1 - jj;
        const int cb = jj & 1;
        const bool more = (jj + 1 < ntile);
        if (more) gload(j - 1);
        const int relmax = qhi - 64 * j, relmin = qlo - (64 * j + 63);
        if (relmax >= 0 && relmin <= J.W) {
            const bool needmask = (relmin < 0) || (relmax > J.W);
            LAS unsigned char* kb_ = lds + cb * ABUF; LAS unsigned char* vb_ = kb_ + KBYTES;
            f32x4 sacc[NC][4];
#pragma unroll
            for (int c = 0; c < NC; ++c)
#pragma unroll
                for (int kb = 0; kb < 4; ++kb) sacc[c][kb] = (f32x4){-mref[c], -mref[c], -mref[c], -mref[c]};
#pragma unroll
            for (int kb = 0; kb < 4; ++kb)
#pragma unroll
                for (int f = 0; f < 4; ++f) {
                    const bf16x8 kf = *(const LAS bf16x8*)(kb_ + (kb * 16 + li) * KSTR + (f * 32 + 8 * g) * 2);
                    const int c = (NC == 2) ? (f >> 1) : 0;
                    sacc[c][kb] = __builtin_amdgcn_mfma_f32_16x16x32_bf16(kf, qf[f], sacc[c][kb], 0, 0, 0);
                }
            if (needmask) {
                asm volatile("" ::: "memory");
#pragma unroll
                for (int kb = 0; kb < 4; ++kb)
#pragma unroll
                    for (int r = 0; r < 4; ++r) { const int rel = qidx - (64 * j + 16 * kb + 4 * g + r);
                        if (rel < 0 || rel > J.W) {
#pragma unroll
                            for (int c = 0; c < NC; ++c) sacc[c][kb][r] = -INFINITY; } }
            }
            bf16x8 pf[NC][2];
#pragma unroll
            for (int c = 0; c < NC; ++c) {
                float tm = fmaxf(fmaxf(sacc[c][0][0], sacc[c][0][1]), fmaxf(sacc[c][0][2], sacc[c][0][3]));
#pragma unroll
                for (int kb = 1; kb < 4; ++kb) tm = fmaxf(fmaxf(tm, sacc[c][kb][0]), fmaxf(fmaxf(sacc[c][kb][1], sacc[c][kb][2]), sacc[c][kb][3]));
                if (first || __any(tm > 8.f)) {
                    asm volatile("" ::: "memory");
                    tm = fmaxf(tm, __shfl_xor(tm, 16)); tm = fmaxf(tm, __shfl_xor(tm, 32));
                    const float delta = first ? tm : fmaxf(tm, 0.f);
                    const float alpha = first ? 1.f : __builtin_amdgcn_exp2f(-delta);
                    mref[c] += delta;
#pragma unroll
                    for (int kb = 0; kb < 4; ++kb) sacc[c][kb] = sacc[c][kb] - delta;
#pragma unroll
                    for (int d = 0; d < 8; ++d) oacc[c][d] = oacc[c][d] * alpha;
                    lacc[c] = lacc[c] * alpha;
                }
                float pv[4][4];
#pragma unroll
                for (int kb = 0; kb < 4; ++kb)
#pragma unroll
                    for (int r = 0; r < 4; ++r) pv[kb][r] = __builtin_amdgcn_exp2f(sacc[c][kb][r]);
#pragma unroll
                for (int kk = 0; kk < 2; ++kk) {
                    u32x4 pk = {pack2(pv[2 * kk][0], pv[2 * kk][1]), pack2(pv[2 * kk][2], pv[2 * kk][3]),
                                pack2(pv[2 * kk + 1][0], pv[2 * kk + 1][1]), pack2(pv[2 * kk + 1][2], pv[2 * kk + 1][3])};
                    pf[c][kk] = __builtin_bit_cast(bf16x8, pk);
                }
            }
            first = false;
#pragma unroll
            for (int kk = 0; kk < 2; ++kk) {
#pragma unroll
                for (int c = 0; c < NC; ++c) lacc[c] = __builtin_amdgcn_mfma_f32_16x16x32_bf16(ones, pf[c][kk], lacc[c], 0, 0, 0);
#pragma unroll
                for (int d = 0; d < 8; ++d) {
                    LAS unsigned char* vp = vb_ + (kk * 32 + 4 * g + (li >> 2)) * VSTR + (li & 3) * 8 + d * 32;
                    const s16x4 lo = __builtin_amdgcn_ds_read_tr16_b64_v4i16((LAS s16x4*)vp);
                    const s16x4 hi = __builtin_amdgcn_ds_read_tr16_b64_v4i16((LAS s16x4*)(vp + 16 * VSTR));
                    const bf16x8 vf = {lo[0], lo[1], lo[2], lo[3], hi[0], hi[1], hi[2], hi[3]};
#pragma unroll
                    for (int c = 0; c < NC; ++c) oacc[c][d] = __builtin_amdgcn_mfma_f32_16x16x32_bf16(vf, pf[c][kk], oacc[c][d], 0, 0, 0);
                }
            }
        }
        if (more) lstore(cb ^ 1);
        __syncthreads();
    }
    float linv[NC], lsum[NC];
#pragma unroll
    for (int c = 0; c < NC; ++c) { lsum[c] = lacc[c][0]; linv[c] = 1.f / lsum[c]; }
    bf16_t* op = J.O + qtok * J.ldo + 4 * g;
    if (NC == 2) {
        float ss = 0.f;
#pragma unroll
        for (int d = 0; d < 8; ++d)
#pragma unroll
            for (int r = 0; r < 4; ++r) { const float v = oacc[0][d][r] * linv[0] - J.lam * oacc[NC - 1][d][r] * linv[NC - 1]; oacc[0][d][r] = v; ss += v * v; }
        ss += __shfl_xor(ss, 16); ss += __shfl_xor(ss, 32);
        const float rs = __builtin_amdgcn_rsqf(ss * (1.f / 128.f) + EPS);
#pragma unroll
        for (int d = 0; d < 8; ++d) { u32x2 o = {pack2(oacc[0][d][0] * rs, oacc[0][d][1] * rs), pack2(oacc[0][d][2] * rs, oacc[0][d][3] * rs)};
            *(u32x2*)(op + 16 * d) = o; }
    } else {
#pragma unroll
        for (int d = 0; d < 8; ++d) { u32x2 o = {pack2(oacc[0][d][0] * linv[0], oacc[0][d][1] * linv[0]), pack2(oacc[0][d][2] * linv[0], oacc[0][d][3] * linv[0])};
            *(u32x2*)(op + 16 * d) = o; }
        if (g == 0) J.lse[qtok * 4] = mref[0] + __builtin_amdgcn_logf(lsum[0]);
    }
}

__device__ void attn_phase(const Params& p, int l, const bf16_t* proj, bf16_t* oab, bf16_t* og, float* lse, LAS unsigned char* lds) {
    const int nbl = p.Mc / SEQ;
    const int nA = nbl * 4 * 16, nB = nbl * 384;
    float lam;
    { const int lane = opaque_tid() & 63; const float* lv = p.diff_lambda + l * 256;
      const float s1 = wave_sum(lv[lane] * lv[64 + lane]), s2 = wave_sum(lv[128 + lane] * lv[192 + lane]);
      lam = __expf(s1) - __expf(s2) + (0.8f - 0.6f * __expf(-0.3f * (float)l)); }
    for (int it = opaque_bid(); it < nA + nB; it += gridDim.x) {
        if (it < nA) {
            const int bh = it >> 4, pi = it & 15, bl = bh >> 2, h = bh & 3;
            const bf16_t* base = proj + (size_t)bl * SEQ * PLD;
            for (int pass = 0; pass < 2; ++pass) {
                AttnJob J; J.Q = base + h * 128; J.K = base + 512 + h * 128; J.V = base + 1024 + h * 128;
                J.t0 = 0; J.dil = 1; J.n = pass == 0 ? 31 - pi : pi; J.jt0 = 0; J.jt1 = 2 * J.n + 2; J.W = 1 << 30;
                J.O = oab + (size_t)bl * SEQ * DM + h * 128; J.ldo = DM; J.lse = nullptr; J.lam = lam;
                attn_job<2>(J, lds);
            }
        } else {
            const int id = it - nA; const int bl = id / 384, rem = id % 384, gi = rem >> 7, h = (rem & 127) >> 5, idx = rem & 31;
            const int dil = 1 << (2 * gi), r = idx & (dil - 1), nblk = idx >> (2 * gi);
            const bf16_t* base = proj + (size_t)bl * SEQ * PLD;
            AttnJob J; J.Q = base + 1536 + gi * 512 + h * 128; J.K = base + 3072 + gi * 512 + h * 128; J.V = base + 4608 + gi * 512 + h * 128;
            J.t0 = r; J.dil = dil; J.n = nblk; J.jt0 = nblk == 0 ? 0 : 2 * nblk - 2; J.jt1 = 2 * nblk + 2; J.W = 128;
            J.O = og + ((size_t)gi * p.Mc + (size_t)bl * SEQ) * 512 + h * 128; J.ldo = 512; J.lse = lse + ((size_t)gi * p.Mc + (size_t)bl * SEQ) * 4 + h; J.lam = 0.f;
            attn_job<1>(J, lds);
        }
    }
}

__device__ void combine_phase(const Params& p, const bf16_t* og, const float* lse, bf16_t* oab) {
    const int tid = opaque_tid(); const int lane = tid & 63, wv = tid >> 6, h = lane >> 4;
    const size_t Mc = p.Mc;
    for (int r = opaque_bid() * 8 + wv; r < p.Mc; r += gridDim.x * 8) {
        const float l0 = lse[(size_t)r * 4 + h], l1 = lse[(Mc + r) * 4 + h], l2 = lse[(2 * Mc + r) * 4 + h];
        const float mx = fmaxf(l0, fmaxf(l1, l2));
        float w0 = __builtin_amdgcn_exp2f(l0 - mx), w1 = __builtin_amdgcn_exp2f(l1 - mx), w2 = __builtin_amdgcn_exp2f(l2 - mx);
        const float inv = 1.f / (w0 + w1 + w2); w0 *= inv; w1 *= inv; w2 *= inv;
        const u32x4 a = *(const u32x4*)(og + (size_t)r * 512 + lane * 8), b = *(const u32x4*)(og + (Mc + r) * 512 + lane * 8), c = *(const u32x4*)(og + (2 * Mc + r) * 512 + lane * 8);
        u32x4 o;
#pragma unroll
        for (int i = 0; i < 4; ++i) o[i] = pack2(w0 * bflo(a[i]) + w1 * bflo(b[i]) + w2 * bflo(c[i]), w0 * bfhi(a[i]) + w1 * bfhi(b[i]) + w2 * bfhi(c[i]));
        *(u32x4*)(oab + (size_t)r * DM + 512 + lane * 8) = o;
    }
}

__device__ __forceinline__ float gelu_tanh(float x) {
    const float t = 0.7978845608028654f * (x + 0.044715f * x * x * x);
    return x * __builtin_amdgcn_rcpf(1.f + __builtin_amdgcn_exp2f(-2.f * LOG2E * t));
}
__device__ void convfix_phase(const Params& p, int l, const bf16_t* edge, bf16_t* a) {
    const int ncg = DFF / 4; const int nitems = (p.Mc / 64) * ncg;
    const float* cw = p.conv_w + (size_t)l * 3 * UPC; const float* cb = p.conv_b + (size_t)l * UPC;
    for (int item = opaque_bid() * 512 + opaque_tid(); item < nitems; item += gridDim.x * 512) {
        const int cg_ = item % ncg, k = item / ncg; const int j0 = cg_ * 4;
        f32x4 wg[3], wv[3];
#pragma unroll
        for (int t = 0; t < 3; ++t) { wg[t] = *(const f32x4*)(cw + t * UPC + j0); wv[t] = *(const f32x4*)(cw + t * UPC + DFF + j0); }
        const f32x4 bg = *(const f32x4*)(cb + j0), bv = *(const f32x4*)(cb + DFF + j0);
        f32x4 g[4], v[4];
        const bool has_prev = ((k * 64) & (SEQ - 1)) != 0;
#pragma unroll
        for (int r = 0; r < 4; ++r) {
            u32x4 raw = {0u, 0u, 0u, 0u};
            if (r >= 2) raw = *(const u32x4*)(edge + ((size_t)k * 4 + (r - 2)) * UPC + 2 * j0);
            else if (has_prev) raw = *(const u32x4*)(edge + ((size_t)(k - 1) * 4 + 2 + r) * UPC + 2 * j0);
#pragma unroll
            for (int c = 0; c < 4; ++c) { g[r][c] = bflo(raw[c]); v[r][c] = bfhi(raw[c]); }
        }
#pragma unroll
        for (int j = 0; j < 2; ++j) {
            const f32x4 cgv = wg[0] * g[j] + wg[1] * g[j + 1] + wg[2] * g[j + 2] + bg;
            const f32x4 cvv = wv[0] * v[j] + wv[1] * v[j + 1] + wv[2] * v[j + 2] + bv;
            u32x2 o = {pack2(gelu_tanh(cgv[0]) * cvv[0], gelu_tanh(cgv[1]) * cvv[1]), pack2(gelu_tanh(cgv[2]) * cvv[2], gelu_tanh(cgv[3]) * cvv[3])};
            *(u32x2*)(a + (size_t)(k * 64 + j) * DFF + j0) = o;
        }
    }
}

#define XB_TMO      128
#define XB_XCNT(j)  (256  + 64 * (j))
#define XB_XSUB(j)  (1280 + 64 * (j))
#define XB_XGEN(j)  (2304 + 64 * (j))
#define XB_TOP      3328
#define XB_TOPGEN   3392
#define XCD_BAR_WORDS 3456
#define XB_SPIN_CAP (1u << 22)
__device__ __forceinline__ unsigned xb_ld(unsigned* p)              { return __hip_atomic_load(p, __ATOMIC_RELAXED, __HIP_MEMORY_SCOPE_AGENT); }
__device__ __forceinline__ unsigned xb_add(unsigned* p, unsigned v) { return __hip_atomic_fetch_add(p, v, __ATOMIC_RELAXED, __HIP_MEMORY_SCOPE_AGENT); }
__device__ __forceinline__ unsigned xb_xcc_id() { return (unsigned)__builtin_amdgcn_s_getreg((3 << 11) | 20) & 0xFu; }
#define XB_SPIN(cond, bar) do { unsigned _sp = 0; while (cond) { __builtin_amdgcn_s_sleep(1); \
    if ((++_sp & 255u) == 0u) { if (xb_ld(&(bar)[XB_TMO])) break; if (_sp > XB_SPIN_CAP) { atomicAdd(&(bar)[XB_TMO], 1u); break; } } } } while (0)
struct XcdBarrier { unsigned* bar; unsigned x; volatile LAS unsigned* st; };
__device__ __forceinline__ XcdBarrier xcd_barrier_post(unsigned* bar, volatile LAS unsigned* st) {
    XcdBarrier b; b.bar = bar; b.x = xb_xcc_id(); b.st = st;
    if (threadIdx.x == 0) (void)xb_add(&bar[XB_XCNT(b.x)], 1u);
    return b;
}
__device__ __forceinline__ void xcd_barrier_complete(unsigned* bar, unsigned x, unsigned& nloc, unsigned& nx) {
    const unsigned G = gridDim.x * gridDim.y * gridDim.z;
    unsigned sum, cnt, mine, sp = 0u;
    for (;;) {
        sum = 0u; cnt = 0u; mine = 0u;
#pragma unroll
        for (unsigned j = 0; j < 16; ++j) { const unsigned c = xb_ld(&bar[XB_XCNT(j)]); sum += c; cnt += (c > 0u) ? 1u : 0u; mine = (j == x) ? c : mine; }
        if (sum == G) break;
        __builtin_amdgcn_s_sleep(1);
        if ((++sp & 255u) == 0u) { if (xb_ld(&bar[XB_TMO])) break; if (sp > XB_SPIN_CAP) { atomicAdd(&bar[XB_TMO], 1u); break; } }
    }
    nloc = mine > 0u ? mine : 1u; nx = cnt > 0u ? cnt : 1u;
}
__device__ __forceinline__ void xcd_barrier(const XcdBarrier& b) {
    asm volatile("s_waitcnt vmcnt(0)" ::: "memory");
    __syncthreads();
    if (threadIdx.x == 0) {
        unsigned* bar = b.bar;
        __builtin_amdgcn_s_waitcnt(0);
        unsigned nloc = b.st[0], nx = b.st[1];
        if (nloc == 0u) { xcd_barrier_complete(bar, b.x, nloc, nx); b.st[0] = nloc; b.st[1] = nx; }
        const unsigned old = xb_add(&bar[XB_XSUB(b.x)], 1u);
        const unsigned gen = old / nloc;
        if (old + 1u == (gen + 1u) * nloc) {
            __builtin_amdgcn_fence(__ATOMIC_RELEASE, "agent");
            asm volatile("s_waitcnt vmcnt(0)" ::: "memory");
            const unsigned og = xb_add(&bar[XB_TOP], 1u);
            const unsigned tg = og / nx;
            if (og + 1u == (tg + 1u) * nx) xb_add(&bar[XB_TOPGEN], 1u);
            else XB_SPIN(xb_ld(&bar[XB_TOPGEN]) == tg, bar);
            __builtin_amdgcn_fence(__ATOMIC_ACQUIRE, "agent");
            xb_add(&bar[XB_XGEN(b.x)], 1u);
            asm volatile("s_waitcnt vmcnt(0)" ::: "memory");
        } else {
            XB_SPIN(xb_ld(&bar[XB_XGEN(b.x)]) == gen, bar);
            __builtin_amdgcn_fence(__ATOMIC_ACQUIRE, "agent");
            asm volatile("s_waitcnt vmcnt(0)" ::: "memory");
        }
    }
    __syncthreads();
}

__device__ __forceinline__ void run_step(const Params& p, int step, LAS unsigned char* lds) {
    unsigned char* ws = p.ws;
    bf16_t* HB = (bf16_t*)(ws + WS_HB);
    const size_t Mc = p.Mc;
    unsigned char* R1 = ws + WS_CH; unsigned char* R2 = R1 + Mc * 16896; unsigned char* R3 = R2 + Mc * 2048; float* LSE = (float*)(R3 + Mc * 5120);
    bf16_t* proj = (bf16_t*)R1; bf16_t* abuf = (bf16_t*)R1; bf16_t* edge = (bf16_t*)(R1 + Mc * 5632);
    bf16_t* zbuf = (bf16_t*)R2; bf16_t* hb2 = (bf16_t*)R2;
    bf16_t* oab = (bf16_t*)R3; bf16_t* og = (bf16_t*)(R3 + Mc * 2048); bf16_t* mix = (bf16_t*)R3;
    if (step == 0) {
        if (!PH_EN(100)) return;
        rowpass(p.x_in, nullptr, nullptr, nullptr, HB, NTOK);
        convert_weights(p, 0, lds);
        return;
    }
    const int s1 = step - 1; const int ph = s1 % NPH; const int lc = s1 / NPH; const int c = lc % p.nchunk, l = lc / p.nchunk;
    const size_t row0 = (size_t)c * Mc;
    pg8::StaticOrder S;
    switch (ph) {
    case 0: if (PH_EN(0)) { pg8::Gemm g{HB + row0 * DM, (const bf16_t*)(ws + W_IN), (int)Mc, INC, DM, DM}; S.init((int)Mc, INC, gridDim.x, opaque_bid());
              pg8::EpiProj E{proj, p.pos + row0}; pg8::gemm_phase(lds, g, S, E); } break;
    case 1: if (PH_EN(1)) attn_phase(p, l, proj, oab, og, LSE, lds); break;
    case 2: if (PH_EN(2)) { pg8::Gemm g{oab, (const bf16_t*)(ws + W_A), (int)Mc, DM, 512, DM}; S.init((int)Mc, DM, gridDim.x, opaque_bid());
              pg8::EpiGate<0> E{zbuf, proj, 6144}; pg8::gemm_phase(lds, g, S, E); combine_phase(p, og, LSE, oab); } break;
    case 3: if (PH_EN(3)) { pg8::Gemm g{oab + 512, (const bf16_t*)(ws + W_B), (int)Mc, DM, 512, DM}; S.init((int)Mc, DM, gridDim.x, opaque_bid());
              pg8::EpiGate<1> E{zbuf, proj, 7168}; pg8::gemm_phase(lds, g, S, E); } break;
    case 4: if (PH_EN(4)) { pg8::Gemm g{zbuf, (const bf16_t*)(ws + W_MIX), (int)Mc, DM, DM, DM}; S.init((int)Mc, DM, gridDim.x, opaque_bid());
              pg8::EpiBf16 E{mix, DM}; pg8::gemm_phase(lds, g, S, E); } break;
    case 5: if (PH_EN(5)) rowpass((l == 0 ? p.x_in : p.out) + row0 * DM, mix, p.post_mix_g + l * DM, p.out + row0 * DM, hb2, (int)Mc); break;
    case 6: if (PH_EN(6)) { pg8::Gemm g{hb2, (const bf16_t*)(ws + W_UP), (int)Mc, UPC, DM, DM}; S.init((int)Mc, UPC, gridDim.x, opaque_bid());
              pg8::EpiConvGlu E{abuf, edge, p.conv_w + (size_t)l * 3 * UPC, p.conv_b + (size_t)l * UPC}; pg8::gemm_phase(lds, g, S, E); } break;
    case 7: if (PH_EN(7)) convfix_phase(p, l, edge, abuf); break;
    case 8: if (PH_EN(8)) { pg8::Gemm g{abuf, (const bf16_t*)(ws + W_DOWN), (int)Mc, DM, DFF, DFF}; S.init((int)Mc, DM, gridDim.x, opaque_bid());
              pg8::EpiBf16 E{mix, DM}; pg8::gemm_phase(lds, g, S, E); } break;
    case 9: if (PH_EN(9)) { rowpass(p.out + row0 * DM, mix, p.post_ffn_g + l * DM, p.out + row0 * DM, (l + 1 < DEPTH) ? HB + row0 * DM : nullptr, (int)Mc);
             if (c == p.nchunk - 1 && l + 1 < DEPTH) { convert_weights(p, l + 1, lds); if (MK_REP == 101) convert_weights(p, l + 1, lds); } }
             break;
    }
}

template <bool COOP>
__global__ void __launch_bounds__(512, 2) mk_fwd(Params p) {
    extern __shared__ __attribute__((aligned(16))) unsigned char smem[];
    LAS unsigned char* lds = (LAS unsigned char*)smem;
    XcdBarrier bar;
    if (COOP) {
        volatile LAS unsigned* st = (volatile LAS unsigned*)(lds + LDS_MAIN);
        if (threadIdx.x == 0) { st[0] = 0u; st[1] = 0u; }
        __syncthreads();
        bar = xcd_barrier_post((unsigned*)(p.ws + WS_BAR), st);
    }
    for (int step = p.ph_lo; step < p.ph_hi; ++step) {
        run_step(p, step, lds);
        if (MK_REP >= 0 && step > 0 && (step - 1) % NPH == MK_REP) { __syncthreads(); run_step(p, step, lds); }
        if (MK_REP == 100 && step == 0) { __syncthreads(); run_step(p, step, lds); }
        if (COOP && step + 1 < p.ph_hi) {
            if (step == p.ph_lo) cg::this_grid().sync();
            else xcd_barrier(bar);
        }
    }
}

extern "C" void kernel_launch(void* const* d_in, const int* in_sizes, int n_in, void* d_out, int out_size, void* d_ws, size_t ws_size, hipStream_t stream) {
    static int grid = 0; static int Mc = 0;
    if (grid == 0) {
        int dev = 0, cus = 0, per_cu = 0;
        hipGetDevice(&dev);
        hipDeviceGetAttribute(&cus, hipDeviceAttributeMultiprocessorCount, dev);
        hipFuncSetAttribute((const void*)mk_fwd<true>, hipFuncAttributeMaxDynamicSharedMemorySize, LDS_BYTES);
        hipFuncSetAttribute((const void*)mk_fwd<false>, hipFuncAttributeMaxDynamicSharedMemorySize, LDS_BYTES);
        hipOccupancyMaxActiveBlocksPerMultiprocessor(&per_cu, (const void*)mk_fwd<true>, 512, LDS_BYTES);
        if (per_cu < 1) per_cu = 1;
        grid = cus * per_cu;
        Mc = NTOK;
        while (Mc > SEQ && WS_CH + (size_t)Mc * PER_TOK > ws_size) Mc >>= 1;
        fprintf(stderr, "kernel_launch: cus %d per_cu %d grid %d Mc %d ws %zu\n", cus, per_cu, grid, Mc, ws_size);
    }
    Params p{};
    p.x_in = (const float*)d_in[0]; p.pos = (const int*)d_in[1]; p.pre_mix_g = (const float*)d_in[2]; p.w_in = (const float*)d_in[3];
    p.diff_lambda = (const float*)d_in[4]; p.diff_head_g = (const float*)d_in[5]; p.w_a_out = (const float*)d_in[6]; p.w_b_out = (const float*)d_in[7];
    p.w_mix_out = (const float*)d_in[8]; p.post_mix_g = (const float*)d_in[9]; p.pre_ffn_g = (const float*)d_in[10]; p.w_up = (const float*)d_in[11];
    p.conv_w = (const float*)d_in[12]; p.conv_b = (const float*)d_in[13]; p.w_down = (const float*)d_in[14]; p.post_ffn_g = (const float*)d_in[15];
    p.out = (float*)d_out; p.ws = (unsigned char*)d_ws; p.Mc = Mc; p.nchunk = NTOK / Mc;
    const int nsteps = 1 + DEPTH * p.nchunk * NPH;
#if MK_SINGLE
    p.ph_lo = 0; p.ph_hi = nsteps;
    if (hipMemsetAsync((char*)d_ws + WS_BAR, 0, WS_BAR_BYTES, stream) != hipSuccess) fprintf(stderr, "memset of barrier words failed\n");
    void* args[] = {&p};
    hipError_t e = hipLaunchCooperativeKernel((const void*)mk_fwd<true>, dim3(grid), dim3(512), args, LDS_BYTES, stream);
    if (e != hipSuccess) fprintf(stderr, "cooperative launch failed: %s (grid %d)\n", hipGetErrorString(e), grid);
#else
    for (int s = 0; s < nsteps; ++s) {
        p.ph_lo = s; p.ph_hi = s + 1;
        hipLaunchKernelGGL(mk_fwd<false>, dim3(grid), dim3(512), LDS_BYTES, stream, p);
    }
#endif
    (void)in_sizes; (void)n_in; (void)out_size;
}
```

```cpp
#include <hip/hip_runtime.h>
#include <hip/hip_cooperative_groups.h>
#include <cstdio>
#include <cstdint>
namespace cg = cooperative_groups;

#ifndef MK_SINGLE
#define MK_SINGLE 1
#endif

#ifndef MK_REP
#define MK_REP -1
#endif
#ifndef MK_ONLY
#define MK_ONLY -1
#endif
#define PH_EN(k) ((MK_ONLY) < 0 || (MK_ONLY) == (k))
#define LAS __attribute__((address_space(3)))
typedef unsigned short bf16_t;
typedef short bf16x8 __attribute__((ext_vector_type(8)));
typedef short s16x4 __attribute__((ext_vector_type(4)));
typedef float f32x4 __attribute__((ext_vector_type(4)));
typedef float f32x2 __attribute__((ext_vector_type(2)));
typedef unsigned u32x4 __attribute__((ext_vector_type(4)));
typedef unsigned u32x2 __attribute__((ext_vector_type(2)));
typedef __bf16 bf2_t __attribute__((ext_vector_type(2)));

constexpr int DM = 1024, NBATCH = 8, SEQ = 4096, DEPTH = 4, NTOK = NBATCH * SEQ, INC = 8192, DFF = 2816, UPC = 2 * DFF;
constexpr int PLD = INC + 64;
constexpr float EPS = 1e-6f;
constexpr float LOG2E = 1.4426950408889634f;
constexpr int NPH = 10;
constexpr int LDS_MAIN = 131072;
constexpr int LDS_BYTES = LDS_MAIN + 16;

constexpr size_t W_IN = 0, W_A = W_IN + (size_t)INC * DM * 2, W_B = W_A + (size_t)DM * 512 * 2, W_MIX = W_B + (size_t)DM * 512 * 2,
                 W_UP = W_MIX + (size_t)DM * DM * 2, W_DOWN = W_UP + (size_t)UPC * DM * 2, W_END = W_DOWN + (size_t)DM * DFF * 2;
constexpr size_t WS_BAR = (W_END + 255) & ~(size_t)255;
constexpr size_t WS_BAR_BYTES = 16384;
constexpr size_t WS_RS = WS_BAR + WS_BAR_BYTES;
constexpr size_t WS_HB = WS_RS + (size_t)NTOK * 4;
constexpr size_t WS_CH = WS_HB + (size_t)NTOK * DM * 2;
constexpr size_t PER_TOK = 16896 + 2048 + 5120 + 48;

struct Params {
    const float* x_in; const int* pos; const float* pre_mix_g; const float* w_in; const float* diff_lambda; const float* diff_head_g;
    const float* w_a_out; const float* w_b_out; const float* w_mix_out; const float* post_mix_g; const float* pre_ffn_g;
    const float* w_up; const float* conv_w; const float* conv_b; const float* w_down; const float* post_ffn_g;
    float* out; unsigned char* ws;
    int Mc, nchunk, ph_lo, ph_hi;
};

__device__ __forceinline__ unsigned pack2(float a, float b) { f32x2 v = {a, b}; bf2_t r = __builtin_convertvector(v, bf2_t); return __builtin_bit_cast(unsigned, r); }
__device__ __forceinline__ float bflo(unsigned u) { return __uint_as_float(u << 16); }
__device__ __forceinline__ float bfhi(unsigned u) { return __uint_as_float(u & 0xffff0000u); }
__device__ __forceinline__ int opaque_tid() { int t = threadIdx.x; asm volatile("" : "+v"(t)); return t; }
__device__ __forceinline__ int opaque_bid() { int t = blockIdx.x; asm volatile("" : "+s"(t)); return t; }
__device__ __forceinline__ float wave_sum(float v) {
#pragma unroll
    for (int o = 32; o > 0; o >>= 1) v += __shfl_xor(v, o);
    return v;
}

namespace pg8 {
constexpr int BM = 256, BK = 64, HALF = 128, HTB = HALF * BK * 2, STAGE_BYTES = 8 * HTB, NXCD = 8, WGM = 8;
__device__ __forceinline__ int lds_byte(int r, int c) { const int st = (r >> 4) * 2 + (c >> 5), rr = r & 15, cc = c & 31, ob = rr * 64 + cc * 2; return st * 1024 + (ob ^ (((ob >> 9) & 1) << 5)); }
__device__ __forceinline__ void stage_rc(int b, int& R, int& C) { const int st = b / 1024, sb = b % 1024, swz = sb ^ (((sb >> 9) & 1) << 5); R = (st >> 1) * 16 + swz / 64; C = (st & 1) * 32 + (swz % 64) / 2; }
__device__ __forceinline__ int perm32(int rho) { const int n = rho >> 4, i = rho & 15; return 8 * (i >> 2) + 4 * n + (i & 3); }

struct Unit { int pm, pn; };
struct Gemm { const bf16_t* A; const bf16_t* Bt; int M, N, K, lda; };

struct StaticOrder {
    int nM, nN, nwg, G, c;
    __device__ void init(int M, int N, int G_, int c_) { nM = M / BM; nN = N / BM; nwg = nM * nN; G = G_; c = c_; }
    __device__ bool next(int i, Unit& u) const {
        const long L = (long)i * G + c; if (L >= nwg) return false;
        int wgid = (int)L; { const int q = nwg / NXCD, r = nwg % NXCD, xcd = wgid % NXCD, off = wgid / NXCD; wgid = (xcd < r ? xcd * (q + 1) : r * (q + 1) + (xcd - r) * q) + off; }
        const int nig = WGM * nN, gid = wgid / nig, fm = gid * WGM, gsz = (nM - fm) < WGM ? (nM - fm) : WGM;
        u.pm = fm + ((wgid % nig) % gsz); u.pn = (wgid % nig) / gsz; return true;
    }
};

template <class Epi>
__device__ __forceinline__ void gemm_phase(LAS unsigned char* lds, const Gemm g, const StaticOrder& S, const Epi& E) {
    const int tid = opaque_tid(), wid = __builtin_amdgcn_readfirstlane(tid >> 6), lane = tid & 63, wr = wid >> 2, wc = wid & 3, fr = lane & 15, fq = lane >> 4;
    const int K = g.K, nt = K / BK, lda = g.lda;
    unsigned voffA[2], voffB[2];
#pragma unroll
    for (int i = 0; i < 2; ++i) { int R, C; stage_rc(tid * 16 + i * 8192, R, C); const int Rb = Epi::PERM ? ((R & ~31) + perm32(R & 31)) : R;
        const int Ra = Epi::ROWPERM ? ((R & ~63) + 4 * (R & 15) + ((R >> 4) & 3)) : R;
        voffA[i] = (unsigned)(Ra * lda + C) * 2u; voffB[i] = (unsigned)(Rb * K + C) * 2u; }
    const size_t kstep = (size_t)(BK * 2);
    const size_t hstepA = (size_t)HALF * lda * 2, hstepB = (size_t)HALF * K * 2;
    const size_t tstepA = 2 * hstepA, tstepB = 2 * hstepB;
    const unsigned ldsw = (unsigned)wid * 1024u;
    const int aoff = lds_byte(wr * 64 + fr, fq * 8), boff = lds_byte(wc * 32 + fr, fq * 8);
#define PG8_SA(b, h) (((b) * 2 + (h)) * HTB)
#define PG8_SB(b, h) ((4 + (b) * 2 + (h)) * HTB)
#define PG8_STAGE(bufoff, gbase, voff) do { _Pragma("unroll") for (int _i = 0; _i < 2; ++_i) \
        __builtin_amdgcn_global_load_lds((const unsigned*)((const char*)(gbase) + (voff)[_i]), (LAS unsigned*)(lds + (bufoff) + ldsw + _i * 8192), 16, 0, 0); } while (0)
#define PG8_LDA(dst, b, h) do { _Pragma("unroll") for (int m = 0; m < 4; ++m) _Pragma("unroll") for (int k = 0; k < 2; ++k) dst[m][k] = *(const LAS bf16x8*)(lds + PG8_SA(b, h) + aoff + m * 2048 + k * 1024); } while (0)
#define PG8_LDB(dst, b, h) do { _Pragma("unroll") for (int n = 0; n < 2; ++n) _Pragma("unroll") for (int k = 0; k < 2; ++k) dst[n][k] = *(const LAS bf16x8*)(lds + PG8_SB(b, h) + boff + n * 2048 + k * 1024); } while (0)
#define PG8_MMA(ai, bj, At, Bt) do { __builtin_amdgcn_s_setprio(1); _Pragma("unroll") for (int m = 0; m < 4; ++m) _Pragma("unroll") for (int n = 0; n < 2; ++n) _Pragma("unroll") for (int k = 0; k < 2; ++k) \
        acc[ai][bj][m][n] = __builtin_amdgcn_mfma_f32_16x16x32_bf16(Bt[n][k], At[m][k], acc[ai][bj][m][n], 0, 0, 0); __builtin_amdgcn_s_setprio(0); } while (0)
#define PG8_WAIT_V(n) asm volatile("s_waitcnt vmcnt(" #n ")" ::: "memory")
#define PG8_WAIT_L(n) asm volatile("s_waitcnt lgkmcnt(" #n ")" ::: "memory")
#define PG8_BAR __builtin_amdgcn_s_barrier()
#define PG8_SCHED __builtin_amdgcn_sched_barrier(0)
    Unit cur, nxt; int ui = 0;
    if (!S.next(0, cur)) return;
    f32x4 acc[2][2][4][2];
#pragma unroll
    for (int a = 0; a < 2; ++a)
#pragma unroll
        for (int b = 0; b < 2; ++b)
#pragma unroll
            for (int m = 0; m < 4; ++m)
#pragma unroll
                for (int n = 0; n < 2; ++n) acc[a][b][m][n] = (f32x4){0.f, 0.f, 0.f, 0.f};
    bf16x8 At[4][2], B0[2][2], B1[2][2];
    const char* cA = (const char*)g.A + (size_t)cur.pm * tstepA; const char* cB = (const char*)g.Bt + (size_t)cur.pn * tstepB;
    PG8_STAGE(PG8_SB(0, 0), cB, voffB); PG8_STAGE(PG8_SA(0, 0), cA, voffA); PG8_STAGE(PG8_SB(0, 1), cB + hstepB, voffB); PG8_STAGE(PG8_SA(0, 1), cA + hstepA, voffA);
    if (wr == 1) PG8_BAR;
    PG8_WAIT_V(4); PG8_BAR;
    PG8_STAGE(PG8_SB(1, 0), cB + kstep, voffB); PG8_STAGE(PG8_SA(1, 0), cA + kstep, voffA); PG8_STAGE(PG8_SB(1, 1), cB + hstepB + kstep, voffB);
    PG8_WAIT_V(6); PG8_BAR;
    for (;;) {
        const bool has_next = S.next(ui + 1, nxt);
        const char* nA = has_next ? (const char*)g.A + (size_t)nxt.pm * tstepA : cA; const char* nB = has_next ? (const char*)g.Bt + (size_t)nxt.pn * tstepB : cB;
        for (int t = 0; t < nt; t += 2) {
            const bool last = (t == nt - 2);
            const char* a1 = cA + (size_t)(t + 1) * kstep;
            const char* a2 = last ? nA : cA + (size_t)(t + 2) * kstep; const char* b2 = last ? nB : cB + (size_t)(t + 2) * kstep;
            const char* a3 = a2 + kstep; const char* b3 = b2 + kstep;
            PG8_LDB(B0, 0, 0); PG8_SCHED; PG8_LDA(At, 0, 0); PG8_STAGE(PG8_SA(1, 1), a1 + hstepA, voffA);
            PG8_WAIT_L(8); PG8_BAR; PG8_WAIT_L(0); PG8_MMA(0, 0, At, B0); PG8_BAR; PG8_SCHED;
            PG8_LDB(B1, 0, 1); PG8_STAGE(PG8_SB(0, 0), b2, voffB);
            PG8_BAR; PG8_WAIT_L(0); PG8_MMA(0, 1, At, B1); PG8_BAR;
            PG8_LDA(At, 0, 1); PG8_STAGE(PG8_SA(0, 0), a2, voffA);
            PG8_BAR; PG8_WAIT_L(0); PG8_MMA(1, 0, At, B0); PG8_BAR; PG8_SCHED;
            PG8_STAGE(PG8_SB(0, 1), b2 + hstepB, voffB);
            PG8_WAIT_V(6); PG8_BAR; PG8_MMA(1, 1, At, B1); PG8_BAR;
            PG8_LDB(B0, 1, 0); PG8_SCHED; PG8_LDA(At, 1, 0); PG8_STAGE(PG8_SA(0, 1), a2 + hstepA, voffA);
            PG8_WAIT_L(8); PG8_BAR; PG8_WAIT_L(0); PG8_MMA(0, 0, At, B0); PG8_BAR; PG8_SCHED;
            PG8_LDB(B1, 1, 1); PG8_STAGE(PG8_SB(1, 0), b3, voffB);
            PG8_BAR; PG8_WAIT_L(0); PG8_MMA(0, 1, At, B1); PG8_BAR;
            PG8_LDA(At, 1, 1); PG8_STAGE(PG8_SA(1, 0), a3, voffA);
            PG8_BAR; PG8_WAIT_L(0); PG8_MMA(1, 0, At, B0); PG8_BAR; PG8_SCHED;
            PG8_STAGE(PG8_SB(1, 1), b3 + hstepB, voffB);
            PG8_WAIT_V(6); PG8_BAR; PG8_MMA(1, 1, At, B1); PG8_BAR;
        }
        E(acc, cur, wr, wc, fr, fq);
        if (!has_next) break;
#pragma unroll
        for (int a = 0; a < 2; ++a)
#pragma unroll
            for (int b = 0; b < 2; ++b)
#pragma unroll
                for (int m = 0; m < 4; ++m)
#pragma unroll
                    for (int n = 0; n < 2; ++n) acc[a][b][m][n] = (f32x4){0.f, 0.f, 0.f, 0.f};
        cur = nxt; cA = nA; cB = nB; ++ui;
    }
    PG8_WAIT_V(0);
    if (wr == 0) PG8_BAR;
    PG8_BAR;
#undef PG8_SA
#undef PG8_SB
#undef PG8_STAGE
#undef PG8_LDA
#undef PG8_LDB
#undef PG8_MMA
#undef PG8_WAIT_V
#undef PG8_WAIT_L
#undef PG8_BAR
#undef PG8_SCHED
}

struct EpiProj {
    static constexpr bool PERM = true, ROWPERM = false;
    bf16_t* O; const int* pos; const float* rs;
    __device__ __forceinline__ void operator()(const f32x4 (&acc)[2][2][4][2], const Unit& u, int wr, int wc, int fr, int fq) const {
        const int pn = u.pn;
        int type;
        if (pn < 4) type = 1; else if (pn < 6) type = 0; else if (pn < 18) type = 2; else if (pn < 24) type = 0; else type = 3;
        float inv[2][4];
#pragma unroll
        for (int bj = 0; bj < 2; ++bj)
#pragma unroll
            for (int i = 0; i < 4; ++i) inv[bj][i] = 0.f;
        if (type == 1 || type == 2) {
            const int dim = type == 1 ? 64 : 128;
            const float c1 = (type == 1 ? (2.f / 64.f) : (2.f / 128.f)) * 13.287712379549449f;
#pragma unroll
            for (int bj = 0; bj < 2; ++bj) {
                const int col = pn * 256 + bj * 128 + wc * 32 + 8 * fq; const int jf0 = (col & (dim - 1)) >> 1;
#pragma unroll
                for (int i = 0; i < 4; ++i) inv[bj][i] = __builtin_amdgcn_exp2f(-(float)(jf0 + i) * c1 - 2.651496129472319f);
            }
        }
#pragma unroll
        for (int ai = 0; ai < 2; ++ai)
#pragma unroll
            for (int m = 0; m < 4; ++m) {
                const int row = u.pm * 256 + ai * 128 + wr * 64 + m * 16 + fr;
                const float posf = (float)pos[row]; const float rsc = rs[row];
#pragma unroll
                for (int bj = 0; bj < 2; ++bj) {
                    const int col = pn * 256 + bj * 128 + wc * 32 + 8 * fq;
                    f32x4 v0 = acc[ai][bj][m][0], v1 = acc[ai][bj][m][1];
                    float v[8] = {v0[0] * rsc, v0[1] * rsc, v0[2] * rsc, v0[3] * rsc, v1[0] * rsc, v1[1] * rsc, v1[2] * rsc, v1[3] * rsc};
                    if (type == 1 || type == 2) {
#pragma unroll
                        for (int i = 0; i < 4; ++i) {
                            float rev = posf * inv[bj][i]; rev -= __builtin_rintf(rev);
                            const float sn = __builtin_amdgcn_sinf(rev), cs = __builtin_amdgcn_cosf(rev);
                            const float x1 = v[2 * i], x2 = v[2 * i + 1];
                            v[2 * i] = x1 * cs - x2 * sn; v[2 * i + 1] = x2 * cs + x1 * sn;
                        }
                    } else if (type == 3) {
#pragma unroll
                        for (int i = 0; i < 8; ++i) v[i] = __builtin_amdgcn_rcpf(1.f + __builtin_amdgcn_exp2f(-v[i] * LOG2E));
                    }
                    u32x4 o = {pack2(v[0], v[1]), pack2(v[2], v[3]), pack2(v[4], v[5]), pack2(v[6], v[7])};
                    *(u32x4*)(O + (size_t)row * PLD + col) = o;
                }
            }
    }
};
struct EpiBf16 {
    static constexpr bool PERM = true, ROWPERM = false;
    bf16_t* O; int ldc;
    __device__ __forceinline__ void operator()(const f32x4 (&acc)[2][2][4][2], const Unit& u, int wr, int wc, int fr, int fq) const {
#pragma unroll
        for (int ai = 0; ai < 2; ++ai)
#pragma unroll
            for (int m = 0; m < 4; ++m) {
                const int row = u.pm * 256 + ai * 128 + wr * 64 + m * 16 + fr;
#pragma unroll
                for (int bj = 0; bj < 2; ++bj) {
                    const int col = u.pn * 256 + bj * 128 + wc * 32 + 8 * fq;
                    f32x4 v0 = acc[ai][bj][m][0], v1 = acc[ai][bj][m][1];
                    u32x4 o = {pack2(v0[0], v0[1]), pack2(v0[2], v0[3]), pack2(v1[0], v1[1]), pack2(v1[2], v1[3])};
                    *(u32x4*)(O + (size_t)row * ldc + col) = o;
                }
            }
    }
};
template <int MODE> struct EpiGate {
    static constexpr bool PERM = true, ROWPERM = false;
    bf16_t* Z; const bf16_t* P; int goff;
    __device__ __forceinline__ void operator()(const f32x4 (&acc)[2][2][4][2], const Unit& u, int wr, int wc, int fr, int fq) const {
#pragma unroll
        for (int ai = 0; ai < 2; ++ai)
#pragma unroll
            for (int m = 0; m < 4; ++m) {
                const int row = u.pm * 256 + ai * 128 + wr * 64 + m * 16 + fr;
#pragma unroll
                for (int bj = 0; bj < 2; ++bj) {
                    const int col = u.pn * 256 + bj * 128 + wc * 32 + 8 * fq;
                    f32x4 v0 = acc[ai][bj][m][0], v1 = acc[ai][bj][m][1];
                    const u32x4 gt = *(const u32x4*)(P + (size_t)row * PLD + goff + col);
                    float r[8] = {v0[0] * bflo(gt[0]), v0[1] * bfhi(gt[0]), v0[2] * bflo(gt[1]), v0[3] * bfhi(gt[1]),
                                  v1[0] * bflo(gt[2]), v1[1] * bfhi(gt[2]), v1[2] * bflo(gt[3]), v1[3] * bfhi(gt[3])};
                    u32x4* zp = (u32x4*)(Z + (size_t)row * DM + col);
                    if (MODE == 1) { const u32x4 zo = *zp;
                        r[0] += bflo(zo[0]); r[1] += bfhi(zo[0]); r[2] += bflo(zo[1]); r[3] += bfhi(zo[1]);
                        r[4] += bflo(zo[2]); r[5] += bfhi(zo[2]); r[6] += bflo(zo[3]); r[7] += bfhi(zo[3]); }
                    u32x4 o = {pack2(r[0], r[1]), pack2(r[2], r[3]), pack2(r[4], r[5]), pack2(r[6], r[7])};
                    *zp = o;
                }
            }
    }
};
struct EpiF32 {
    static constexpr bool PERM = false, ROWPERM = false;
    float* C; int ldc;
    __device__ __forceinline__ void operator()(const f32x4 (&acc)[2][2][4][2], const Unit& u, int wr, int wc, int fr, int fq) const {
#pragma unroll
        for (int ai = 0; ai < 2; ++ai)
#pragma unroll
            for (int m = 0; m < 4; ++m) {
                float* rowp = C + (size_t)(u.pm * 256 + ai * 128 + wr * 64 + m * 16 + fr) * ldc + u.pn * 256 + wc * 32 + 4 * fq;
#pragma unroll
                for (int bj = 0; bj < 2; ++bj)
#pragma unroll
                    for (int n = 0; n < 2; ++n) *(f32x4*)(rowp + bj * 128 + n * 16) = acc[ai][bj][m][n];
            }
    }
};

__device__ __forceinline__ float gelu_tanh_e(float x) {
    const float t = 0.7978845608028654f * (x + 0.044715f * x * x * x);
    return x * __builtin_amdgcn_rcpf(1.f + __builtin_amdgcn_exp2f(-2.f * LOG2E * t));
}
__device__ __forceinline__ float dpp_shr1(float v) { return __builtin_bit_cast(float, __builtin_amdgcn_update_dpp(0, __builtin_bit_cast(int, v), 0x111, 0xf, 0xf, true)); }
struct EpiConvGlu {
    static constexpr bool PERM = true, ROWPERM = true;
    bf16_t* Aout; bf16_t* edge; const float* cw; const float* cb; const float* rs;
    __device__ __forceinline__ void operator()(const f32x4 (&acc)[2][2][4][2], const Unit& u, int wr, int wc, int fr, int fq) const {
#pragma unroll
        for (int bj = 0; bj < 2; ++bj) {
            const int col = u.pn * 256 + bj * 128 + wc * 32 + 8 * fq;
            const int ch = col >> 1;
            f32x4 wg[3], wv[3];
#pragma unroll
            for (int t = 0; t < 3; ++t) { wg[t] = *(const f32x4*)(cw + t * UPC + ch); wv[t] = *(const f32x4*)(cw + t * UPC + DFF + ch); }
            const f32x4 bg = *(const f32x4*)(cb + ch), bv = *(const f32x4*)(cb + DFF + ch);
#pragma unroll
            for (int ai = 0; ai < 2; ++ai) {
                const int tok0 = u.pm * 256 + ai * 128 + wr * 64;
                f32x4 G[4], V[4];
#pragma unroll
                for (int m = 0; m < 4; ++m) { const float rsc = rs[tok0 + 4 * fr + m]; const f32x4 a0 = acc[ai][bj][m][0] * rsc, a1 = acc[ai][bj][m][1] * rsc;
                    G[m] = (f32x4){a0[0], a0[2], a1[0], a1[2]}; V[m] = (f32x4){a0[1], a0[3], a1[1], a1[3]}; }
                f32x4 Gp3, Gp2, Vp3, Vp2;
#pragma unroll
                for (int k = 0; k < 4; ++k) { Gp3[k] = dpp_shr1(G[3][k]); Gp2[k] = dpp_shr1(G[2][k]); Vp3[k] = dpp_shr1(V[3][k]); Vp2[k] = dpp_shr1(V[2][k]); }
                bf16_t* eb = edge + (size_t)(tok0 >> 6) * 4 * UPC + col;
                if (fr == 0) {
#pragma unroll
                    for (int m = 0; m < 2; ++m) { u32x4 o = {pack2(G[m][0], V[m][0]), pack2(G[m][1], V[m][1]), pack2(G[m][2], V[m][2]), pack2(G[m][3], V[m][3])}; *(u32x4*)(eb + (size_t)m * UPC) = o; }
                }
                if (fr == 15) {
#pragma unroll
                    for (int m = 2; m < 4; ++m) { u32x4 o = {pack2(G[m][0], V[m][0]), pack2(G[m][1], V[m][1]), pack2(G[m][2], V[m][2]), pack2(G[m][3], V[m][3])}; *(u32x4*)(eb + (size_t)m * UPC) = o; }
                }
#pragma unroll
                for (int m = 0; m < 4; ++m) {
                    const f32x4 g1 = (m >= 1) ? G[m >= 1 ? m - 1 : 0] : Gp3, g2 = (m >= 2) ? G[m >= 2 ? m - 2 : 0] : (m == 1 ? Gp3 : Gp2);
                    const f32x4 v1 = (m >= 1) ? V[m >= 1 ? m - 1 : 0] : Vp3, v2 = (m >= 2) ? V[m >= 2 ? m - 2 : 0] : (m == 1 ? Vp3 : Vp2);
                    const f32x4 cg_ = wg[0] * g2 + wg[1] * g1 + wg[2] * G[m] + bg;
                    const f32x4 cv_ = wv[0] * v2 + wv[1] * v1 + wv[2] * V[m] + bv;
                    u32x2 o = {pack2(gelu_tanh_e(cg_[0]) * cv_[0], gelu_tanh_e(cg_[1]) * cv_[1]), pack2(gelu_tanh_e(cg_[2]) * cv_[2], gelu_tanh_e(cg_[3]) * cv_[3])};
                    *(u32x2*)(Aout + (size_t)(tok0 + 4 * fr + m) * DFF + ch) = o;
                }
            }
        }
    }
};
}

__device__ __forceinline__ void convert_matrix(const float* __restrict__ src, bf16_t* __restrict__ dst, int K, int N, int kind, const float* __restrict__ rowg, float rowmul,
                                               int tile0, int ntiles_total_before, int& item, int stride, LAS float* tile) {
    const int nTk = K / 64, nT = (N / 64) * nTk;
    const int tid = opaque_tid();
    while (item < ntiles_total_before + nT) {
        const int t = item - ntiles_total_before; const int tn = t / nTk, tk = t % nTk;
        {
            const int nl = tid & 63, kl0 = tid >> 6; const int ns = tn * 64 + nl;
            int no = ns; float cs = 1.f;
            if (kind == 0) {
                if (ns < 1024) { const int pp = ns & 63; no = (ns & ~63) + (pp & 1) * 32 + (pp >> 1); if (ns < 512) cs = 0.125f * LOG2E; }
                else if (ns >= 1536 && ns < 4608) { const int pp = ns & 127; no = (ns & ~127) + (pp & 1) * 64 + (pp >> 1); if (ns < 3072) cs = 0.08838834764831845f * LOG2E; }
            } else if (kind == 4) { no = (ns & 1) ? DFF + (ns >> 1) : (ns >> 1); }
#pragma unroll
            for (int i = 0; i < 8; ++i) { const int kl = kl0 + 8 * i, k = tk * 64 + kl;
                float v = src[(size_t)k * N + no] * cs;
                if (rowg) v *= rowg[(kind == 1) ? (k & 127) : k] * rowmul;
                tile[kl * 65 + nl] = v; }
        }
        __syncthreads();
        {
            const int kl = tid & 63, nl0 = tid >> 6;
#pragma unroll
            for (int i = 0; i < 8; ++i) { const int nl = nl0 + 8 * i;
                const unsigned pk = pack2(tile[kl * 65 + nl], 0.f);
                dst[(size_t)(tn * 64 + nl) * K + tk * 64 + kl] = (bf16_t)(pk & 0xffffu); }
        }
        __syncthreads();
        item += stride;
    }
    (void)tile0;
}

__device__ void convert_weights(const Params& p, int l, LAS unsigned char* lds) {
    LAS float* tile = (LAS float*)lds;
    unsigned char* ws = p.ws;
    int item = opaque_bid(); const int stride = gridDim.x; int before = 0;
    const float lam_init = 0.8f - 0.6f * __expf(-0.3f * (float)l);
    convert_matrix(p.w_in + (size_t)l * DM * INC, (bf16_t*)(ws + W_IN), DM, INC, 0, p.pre_mix_g + l * DM, 1.f, 0, before, item, stride, tile); before += (INC / 64) * (DM / 64);
    convert_matrix(p.w_a_out + (size_t)l * 512 * DM, (bf16_t*)(ws + W_A), 512, DM, 1, p.diff_head_g + l * 128, 1.f - lam_init, 0, before, item, stride, tile); before += (DM / 64) * (512 / 64);
    convert_matrix(p.w_b_out + (size_t)l * 512 * DM, (bf16_t*)(ws + W_B), 512, DM, 2, nullptr, 1.f, 0, before, item, stride, tile); before += (DM / 64) * (512 / 64);
    convert_matrix(p.w_mix_out + (size_t)l * DM * DM, (bf16_t*)(ws + W_MIX), DM, DM, 2, nullptr, 1.f, 0, before, item, stride, tile); before += (DM / 64) * (DM / 64);
    convert_matrix(p.w_up + (size_t)l * DM * UPC, (bf16_t*)(ws + W_UP), DM, UPC, 4, p.pre_ffn_g + l * DM, 1.f, 0, before, item, stride, tile); before += (UPC / 64) * (DM / 64);
    convert_matrix(p.w_down + (size_t)l * DFF * DM, (bf16_t*)(ws + W_DOWN), DFF, DM, 2, nullptr, 1.f, 0, before, item, stride, tile);
}

__device__ void rowpass(const float* __restrict__ xsrc32, bf16_t* __restrict__ x16, const bf16_t* __restrict__ add, const float* __restrict__ g, float* __restrict__ out32, float* __restrict__ rs_out, int rows) {
    const int tid = opaque_tid(); const int lane = tid & 63, wv = tid >> 6;
    constexpr int NR = 2;
    const int rstride = gridDim.x * 8;
    for (int r0 = opaque_bid() * 8 + wv; r0 < rows; r0 += rstride * NR) {
        f32x4 xv[NR][4]; u32x2 avr[NR][4];
#pragma unroll
        for (int q = 0; q < NR; ++q) { const int r = r0 + q * rstride;
            if (r < rows) {
                if (xsrc32) {
#pragma unroll
                    for (int i = 0; i < 4; ++i) xv[q][i] = *(const f32x4*)(xsrc32 + (size_t)r * DM + i * 256 + lane * 4);
                } else {
#pragma unroll
                    for (int i = 0; i < 4; ++i) { const u32x2 t = *(const u32x2*)(x16 + (size_t)r * DM + i * 256 + lane * 4); xv[q][i] = (f32x4){bflo(t[0]), bfhi(t[0]), bflo(t[1]), bfhi(t[1])}; }
                }
                if (add) {
#pragma unroll
                    for (int i = 0; i < 4; ++i) avr[q][i] = *(const u32x2*)(add + (size_t)r * DM + i * 256 + lane * 4);
                }
            } }
#pragma unroll
        for (int q = 0; q < NR; ++q) { const int r = r0 + q * rstride;
            if (r < rows) {
                if (add) {
                    f32x4 av[4];
#pragma unroll
                    for (int i = 0; i < 4; ++i) av[i] = (f32x4){bflo(avr[q][i][0]), bfhi(avr[q][i][0]), bflo(avr[q][i][1]), bfhi(avr[q][i][1])};
                    float ss = 0.f;
#pragma unroll
                    for (int i = 0; i < 4; ++i) ss += av[i][0] * av[i][0] + av[i][1] * av[i][1] + av[i][2] * av[i][2] + av[i][3] * av[i][3];
                    ss = wave_sum(ss);
                    const float rs = __builtin_amdgcn_rsqf(ss * (1.f / DM) + EPS);
#pragma unroll
                    for (int i = 0; i < 4; ++i) { const f32x4 gv = *(const f32x4*)(g + i * 256 + lane * 4); xv[q][i] = xv[q][i] + av[i] * gv * rs; }
                }
                if (out32) {
#pragma unroll
                    for (int i = 0; i < 4; ++i) *(f32x4*)(out32 + (size_t)r * DM + i * 256 + lane * 4) = xv[q][i];
                } else {
                    float ss = 0.f;
#pragma unroll
                    for (int i = 0; i < 4; ++i) ss += xv[q][i][0] * xv[q][i][0] + xv[q][i][1] * xv[q][i][1] + xv[q][i][2] * xv[q][i][2] + xv[q][i][3] * xv[q][i][3];
                    ss = wave_sum(ss);
                    if (lane == 0) rs_out[r] = __builtin_amdgcn_rsqf(ss * (1.f / DM) + EPS);
#pragma unroll
                    for (int i = 0; i < 4; ++i) { u32x2 o = {pack2(xv[q][i][0], xv[q][i][1]), pack2(xv[q][i][2], xv[q][i][3])};
                        *(u32x2*)(x16 + (size_t)r * DM + i * 256 + lane * 4) = o; }
                }
            } }
    }
}

struct AttnJob {
    const bf16_t* Q; const bf16_t* K; const bf16_t* V;
    int t0, dil, n, jt0, jt1, W;
    bf16_t* O; int ldo; float* lse; float lam;
};
constexpr int KSTR = 272, VSTR = 288, KBYTES = 64 * KSTR, VBYTES = 64 * VSTR, ABUF = KBYTES + VBYTES;

template <int NC>
__device__ __forceinline__ void attn_job(const AttnJob& J, LAS unsigned char* lds) {
    const int tid = opaque_tid(), lane = tid & 63, w = __builtin_amdgcn_readfirstlane(tid >> 6), li = lane & 15, g = lane >> 4;
    const int qidx = J.n * 128 + w * 16 + li;
    const size_t qtok = (size_t)J.t0 + (size_t)J.dil * qidx;
    bf16x8 qf[4];
    { const bf16_t* qp = J.Q + qtok * PLD + 8 * g;
#pragma unroll
      for (int f = 0; f < 4; ++f) qf[f] = *(const bf16x8*)(qp + f * 32); }
    f32x4 oacc[NC][8], lacc[NC];
#pragma unroll
    for (int c = 0; c < NC; ++c) { lacc[c] = (f32x4){0.f, 0.f, 0.f, 0.f};
#pragma unroll
        for (int d = 0; d < 8; ++d) oacc[c][d] = (f32x4){0.f, 0.f, 0.f, 0.f}; }
    float mref[NC];
#pragma unroll
    for (int c = 0; c < NC; ++c) mref[c] = 0.f;
    bool first = true;
    const bf16x8 ones = {16256, 16256, 16256, 16256, 16256, 16256, 16256, 16256};

    const int srow = tid >> 4, sch = tid & 15;
    u32x4 kst[2], vst[2];
    auto gload = [&](int j) {
#pragma unroll
        for (int i = 0; i < 2; ++i) { const size_t tok = (size_t)J.t0 + (size_t)J.dil * (64 * j + srow + 32 * i);
            kst[i] = *(const u32x4*)(J.K + tok * PLD + sch * 8); vst[i] = *(const u32x4*)(J.V + tok * PLD + sch * 8); }
    };
    auto lstore = [&](int b) {
#pragma unroll
        for (int i = 0; i < 2; ++i) { *(LAS u32x4*)(lds + b * ABUF + (srow + 32 * i) * KSTR + sch * 16) = kst[i];
            *(LAS u32x4*)(lds + b * ABUF + KBYTES + (srow + 32 * i) * VSTR + sch * 16) = vst[i]; }
    };
    const int ntile = J.jt1 - J.jt0;
    gload(J.jt1 - 1); lstore(0);
    __syncthreads();
    const int qlo = J.n * 128 + w * 16, qhi = qlo + 15;
    for (int jj = 0; jj < ntile; ++jj) {
        const int j = J.jt1 - 1 - jj;
        const int cb = jj & 1;
        const bool more = (jj + 1 < ntile);
        if (more) gload(j - 1);
        const int relmax = qhi - 64 * j, relmin = qlo - (64 * j + 63);
        if (relmax >= 0 && relmin <= J.W) {
            const bool needmask = (relmin < 0) || (relmax > J.W);
            LAS unsigned char* kb_ = lds + cb * ABUF; LAS unsigned char* vb_ = kb_ + KBYTES;
            f32x4 sacc[NC][4];
#pragma unroll
            for (int c = 0; c < NC; ++c)
#pragma unroll
                for (int kb = 0; kb < 4; ++kb) sacc[c][kb] = (f32x4){-mref[c], -mref[c], -mref[c], -mref[c]};
            {
                bf16x8 kf[4][4];
#pragma unroll
                for (int f = 0; f < 4; ++f)
#pragma unroll
                    for (int kb = 0; kb < 4; ++kb) kf[f][kb] = *(const LAS bf16x8*)(kb_ + (kb * 16 + li) * KSTR + (f * 32 + 8 * g) * 2);
                __builtin_amdgcn_sched_barrier(0);
#pragma unroll
                for (int f = 0; f < 4; ++f)
#pragma unroll
                    for (int kb = 0; kb < 4; ++kb) { const int c = (NC == 2) ? (f >> 1) : 0;
                        sacc[c][kb] = __builtin_amdgcn_mfma_f32_16x16x32_bf16(kf[f][kb], qf[f], sacc[c][kb], 0, 0, 0); }
                __builtin_amdgcn_sched_barrier(0);
            }
            bf16x8 vf0[8], vf1[8];
#pragma unroll
            for (int d = 0; d < 8; ++d) {
                LAS unsigned char* vp = vb_ + (4 * g + (li >> 2)) * VSTR + (li & 3) * 8 + d * 32;
                const s16x4 lo = __builtin_amdgcn_ds_read_tr16_b64_v4i16((LAS s16x4*)vp);
                const s16x4 hi = __builtin_amdgcn_ds_read_tr16_b64_v4i16((LAS s16x4*)(vp + 16 * VSTR));
                vf0[d] = (bf16x8){lo[0], lo[1], lo[2], lo[3], hi[0], hi[1], hi[2], hi[3]};
            }
            __builtin_amdgcn_sched_barrier(0);
            if (needmask) {
                asm volatile("" ::: "memory");
#pragma unroll
                for (int kb = 0; kb < 4; ++kb)
#pragma unroll
                    for (int r = 0; r < 4; ++r) { const int rel = qidx - (64 * j + 16 * kb + 4 * g + r);
                        if (rel < 0 || rel > J.W) {
#pragma unroll
                            for (int c = 0; c < NC; ++c) sacc[c][kb][r] = -INFINITY; } }
            }
            bf16x8 pf[NC][2];
#pragma unroll
            for (int c = 0; c < NC; ++c) {
                float tm = fmaxf(fmaxf(sacc[c][0][0], sacc[c][0][1]), fmaxf(sacc[c][0][2], sacc[c][0][3]));
#pragma unroll
                for (int kb = 1; kb < 4; ++kb) tm = fmaxf(fmaxf(tm, sacc[c][kb][0]), fmaxf(fmaxf(sacc[c][kb][1], sacc[c][kb][2]), sacc[c][kb][3]));
                if (first || __any(tm > 8.f)) {
                    asm volatile("" ::: "memory");
                    tm = fmaxf(tm, __shfl_xor(tm, 16)); tm = fmaxf(tm, __shfl_xor(tm, 32));
                    const float delta = first ? tm : fmaxf(tm, 0.f);
                    const float alpha = first ? 1.f : __builtin_amdgcn_exp2f(-delta);
                    mref[c] += delta;
#pragma unroll
                    for (int kb = 0; kb < 4; ++kb) sacc[c][kb] = sacc[c][kb] - delta;
#pragma unroll
                    for (int d = 0; d < 8; ++d) oacc[c][d] = oacc[c][d] * alpha;
                    lacc[c] = lacc[c] * alpha;
                }
                float pv[4][4];
#pragma unroll
                for (int kb = 0; kb < 4; ++kb)
#pragma unroll
                    for (int r = 0; r < 4; ++r) pv[kb][r] = __builtin_amdgcn_exp2f(sacc[c][kb][r]);
#pragma unroll
                for (int kk = 0; kk < 2; ++kk) {
                    u32x4 pk = {pack2(pv[2 * kk][0], pv[2 * kk][1]), pack2(pv[2 * kk][2], pv[2 * kk][3]),
                                pack2(pv[2 * kk + 1][0], pv[2 * kk + 1][1]), pack2(pv[2 * kk + 1][2], pv[2 * kk + 1][3])};
                    pf[c][kk] = __builtin_bit_cast(bf16x8, pk);
                }
            }
            first = false;
            __builtin_amdgcn_sched_barrier(0);
#pragma unroll
            for (int d = 0; d < 8; ++d) {
                LAS unsigned char* vp = vb_ + (32 + 4 * g + (li >> 2)) * VSTR + (li & 3) * 8 + d * 32;
                const s16x4 lo = __builtin_amdgcn_ds_read_tr16_b64_v4i16((LAS s16x4*)vp);
                const s16x4 hi = __builtin_amdgcn_ds_read_tr16_b64_v4i16((LAS s16x4*)(vp + 16 * VSTR));
                vf1[d] = (bf16x8){lo[0], lo[1], lo[2], lo[3], hi[0], hi[1], hi[2], hi[3]};
            }
            __builtin_amdgcn_sched_barrier(0);
#pragma unroll
            for (int c = 0; c < NC; ++c) lacc[c] = __builtin_amdgcn_mfma_f32_16x16x32_bf16(ones, pf[c][0], lacc[c], 0, 0, 0);
#pragma unroll
            for (int d = 0; d < 8; ++d)
#pragma unroll
                for (int c = 0; c < NC; ++c) oacc[c][d] = __builtin_amdgcn_mfma_f32_16x16x32_bf16(vf0[d], pf[c][0], oacc[c][d], 0, 0, 0);
            __builtin_amdgcn_sched_barrier(0);
#pragma unroll
            for (int c = 0; c < NC; ++c) lacc[c] = __builtin_amdgcn_mfma_f32_16x16x32_bf16(ones, pf[c][1], lacc[c], 0, 0, 0);
#pragma unroll
            for (int d = 0; d < 8; ++d)
#pragma unroll
                for (int c = 0; c < NC; ++c) oacc[c][d] = __builtin_amdgcn_mfma_f32_16x16x32_bf16(vf1[d], pf[c][1], oacc[c][d], 0, 0, 0);
        }
        if (more) lstore(cb ^ 1);
        __syncthreads();
    }
    float linv[NC], lsum[NC];
#pragma unroll
    for (int c = 0; c < NC; ++c) { lsum[c] = lacc[c][0]; linv[c] = 1.f / lsum[c]; }
    bf16_t* op = J.O + qtok * J.ldo + 4 * g;
    if (NC == 2) {
        float ss = 0.f;
#pragma unroll
        for (int d = 0; d < 8; ++d)
#pragma unroll
            for (int r = 0; r < 4; ++r) { const float v = oacc[0][d][r] * linv[0] - J.lam * oacc[NC - 1][d][r] * linv[NC - 1]; oacc[0][d][r] = v; ss += v * v; }
        ss += __shfl_xor(ss, 16); ss += __shfl_xor(ss, 32);
        const float rs = __builtin_amdgcn_rsqf(ss * (1.f / 128.f) + EPS);
#pragma unroll
        for (int d = 0; d < 8; ++d) { u32x2 o = {pack2(oacc[0][d][0] * rs, oacc[0][d][1] * rs), pack2(oacc[0][d][2] * rs, oacc[0][d][3] * rs)};
            *(u32x2*)(op + 16 * d) = o; }
    } else {
#pragma unroll
        for (int d = 0; d < 8; ++d) { u32x2 o = {pack2(oacc[0][d][0] * linv[0], oacc[0][d][1] * linv[0]), pack2(oacc[0][d][2] * linv[0], oacc[0][d][3] * linv[0])};
            *(u32x2*)(op + 16 * d) = o; }
        if (g == 0) J.lse[qtok * 4] = mref[0] + __builtin_amdgcn_logf(lsum[0]);
    }
}

__device__ void attn_phase(const Params& p, int l, const bf16_t* proj, bf16_t* oab, bf16_t* og, float* lse, LAS unsigned char* lds) {
    const int nbl = p.Mc / SEQ;
    const int nA = nbl * 4 * 16, nB = nbl * 384;
    float lam;
    { const int lane = opaque_tid() & 63; const float* lv = p.diff_lambda + l * 256;
      const float s1 = wave_sum(lv[lane] * lv[64 + lane]), s2 = wave_sum(lv[128 + lane] * lv[192 + lane]);
      lam = __expf(s1) - __expf(s2) + (0.8f - 0.6f * __expf(-0.3f * (float)l)); }
    for (int it = opaque_bid(); it < nA + nB; it += gridDim.x) {
        if (it < nA) {
            const int bh = it >> 4, pi = it & 15, bl = bh >> 2, h = bh & 3;
            const bf16_t* base = proj + (size_t)bl * SEQ * PLD;
            for (int pass = 0; pass < 2; ++pass) {
                AttnJob J; J.Q = base + h * 128; J.K = base + 512 + h * 128; J.V = base + 1024 + h * 128;
                J.t0 = 0; J.dil = 1; J.n = pass == 0 ? 31 - pi : pi; J.jt0 = 0; J.jt1 = 2 * J.n + 2; J.W = 1 << 30;
                J.O = oab + (size_t)bl * SEQ * DM + h * 128; J.ldo = DM; J.lse = nullptr; J.lam = lam;
                attn_job<2>(J, lds);
            }
        } else {
            const int id = it - nA; const int bl = id / 384, rem = id % 384, gi = rem >> 7, h = (rem & 127) >> 5, idx = rem & 31;
            const int dil = 1 << (2 * gi), r = idx & (dil - 1), nblk = idx >> (2 * gi);
            const bf16_t* base = proj + (size_t)bl * SEQ * PLD;
            AttnJob J; J.Q = base + 1536 + gi * 512 + h * 128; J.K = base + 3072 + gi * 512 + h * 128; J.V = base + 4608 + gi * 512 + h * 128;
            J.t0 = r; J.dil = dil; J.n = nblk; J.jt0 = nblk == 0 ? 0 : 2 * nblk - 2; J.jt1 = 2 * nblk + 2; J.W = 128;
            J.O = og + ((size_t)gi * p.Mc + (size_t)bl * SEQ) * 512 + h * 128; J.ldo = 512; J.lse = lse + ((size_t)gi * p.Mc + (size_t)bl * SEQ) * 4 + h; J.lam = 0.f;
            attn_job<1>(J, lds);
        }
    }
}

__device__ void combine_phase(const Params& p, const bf16_t* og, const float* lse, bf16_t* oab) {
    const int tid = opaque_tid(); const int lane = tid & 63, wv = tid >> 6, h = lane >> 4;
    const size_t Mc = p.Mc;
    for (int r = opaque_bid() * 8 + wv; r < p.Mc; r += gridDim.x * 8) {
        const float l0 = lse[(size_t)r * 4 + h], l1 = lse[(Mc + r) * 4 + h], l2 = lse[(2 * Mc + r) * 4 + h];
        const float mx = fmaxf(l0, fmaxf(l1, l2));
        float w0 = __builtin_amdgcn_exp2f(l0 - mx), w1 = __builtin_amdgcn_exp2f(l1 - mx), w2 = __builtin_amdgcn_exp2f(l2 - mx);
        const float inv = 1.f / (w0 + w1 + w2); w0 *= inv; w1 *= inv; w2 *= inv;
        const u32x4 a = *(const u32x4*)(og + (size_t)r * 512 + lane * 8), b = *(const u32x4*)(og + (Mc + r) * 512 + lane * 8), c = *(const u32x4*)(og + (2 * Mc + r) * 512 + lane * 8);
        u32x4 o;
#pragma unroll
        for (int i = 0; i < 4; ++i) o[i] = pack2(w0 * bflo(a[i]) + w1 * bflo(b[i]) + w2 * bflo(c[i]), w0 * bfhi(a[i]) + w1 * bfhi(b[i]) + w2 * bfhi(c[i]));
        *(u32x4*)(oab + (size_t)r * DM + 512 + lane * 8) = o;
    }
}

__device__ __forceinline__ float gelu_tanh(float x) {
    const float t = 0.7978845608028654f * (x + 0.044715f * x * x * x);
    return x * __builtin_amdgcn_rcpf(1.f + __builtin_amdgcn_exp2f(-2.f * LOG2E * t));
}
__device__ void convfix_phase(const Params& p, int l, const bf16_t* edge, bf16_t* a) {
    const int ncg = DFF / 4; const int nitems = (p.Mc / 64) * ncg;
    const float* cw = p.conv_w + (size_t)l * 3 * UPC; const float* cb = p.conv_b + (size_t)l * UPC;
    for (int item = opaque_bid() * 512 + opaque_tid(); item < nitems; item += gridDim.x * 512) {
        const int cg_ = item % ncg, k = item / ncg; const int j0 = cg_ * 4;
        f32x4 wg[3], wv[3];
#pragma unroll
        for (int t = 0; t < 3; ++t) { wg[t] = *(const f32x4*)(cw + t * UPC + j0); wv[t] = *(const f32x4*)(cw + t * UPC + DFF + j0); }
        const f32x4 bg = *(const f32x4*)(cb + j0), bv = *(const f32x4*)(cb + DFF + j0);
        f32x4 g[4], v[4];
        const bool has_prev = ((k * 64) & (SEQ - 1)) != 0;
#pragma unroll
        for (int r = 0; r < 4; ++r) {
            u32x4 raw = {0u, 0u, 0u, 0u};
            if (r >= 2) raw = *(const u32x4*)(edge + ((size_t)k * 4 + (r - 2)) * UPC + 2 * j0);
            else if (has_prev) raw = *(const u32x4*)(edge + ((size_t)(k - 1) * 4 + 2 + r) * UPC + 2 * j0);
#pragma unroll
            for (int c = 0; c < 4; ++c) { g[r][c] = bflo(raw[c]); v[r][c] = bfhi(raw[c]); }
        }
#pragma unroll
        for (int j = 0; j < 2; ++j) {
            const f32x4 cgv = wg[0] * g[j] + wg[1] * g[j + 1] + wg[2] * g[j + 2] + bg;
            const f32x4 cvv = wv[0] * v[j] + wv[1] * v[j + 1] + wv[2] * v[j + 2] + bv;
            u32x2 o = {pack2(gelu_tanh(cgv[0]) * cvv[0], gelu_tanh(cgv[1]) * cvv[1]), pack2(gelu_tanh(cgv[2]) * cvv[2], gelu_tanh(cgv[3]) * cvv[3])};
            *(u32x2*)(a + (size_t)(k * 64 + j) * DFF + j0) = o;
        }
    }
}

#define XB_TMO      128
#define XB_XCNT(j)  (256  + 64 * (j))
#define XB_XSUB(j)  (1280 + 64 * (j))
#define XB_XGEN(j)  (2304 + 64 * (j))
#define XB_TOP      3328
#define XB_TOPGEN   3392
#define XCD_BAR_WORDS 3456
#define XB_SPIN_CAP (1u << 22)
__device__ __forceinline__ unsigned xb_ld(unsigned* p)              { return __hip_atomic_load(p, __ATOMIC_RELAXED, __HIP_MEMORY_SCOPE_AGENT); }
__device__ __forceinline__ unsigned xb_add(unsigned* p, unsigned v) { return __hip_atomic_fetch_add(p, v, __ATOMIC_RELAXED, __HIP_MEMORY_SCOPE_AGENT); }
__device__ __forceinline__ unsigned xb_xcc_id() { return (unsigned)__builtin_amdgcn_s_getreg((3 << 11) | 20) & 0xFu; }
#define XB_SPIN(cond, bar) do { unsigned _sp = 0; while (cond) { __builtin_amdgcn_s_sleep(1); \
    if ((++_sp & 255u) == 0u) { if (xb_ld(&(bar)[XB_TMO])) break; if (_sp > XB_SPIN_CAP) { atomicAdd(&(bar)[XB_TMO], 1u); break; } } } } while (0)
struct XcdBarrier { unsigned* bar; unsigned x; volatile LAS unsigned* st; };
__device__ __forceinline__ XcdBarrier xcd_barrier_post(unsigned* bar, volatile LAS unsigned* st) {
    XcdBarrier b; b.bar = bar; b.x = xb_xcc_id(); b.st = st;
    if (threadIdx.x == 0) (void)xb_add(&bar[XB_XCNT(b.x)], 1u);
    return b;
}
__device__ __forceinline__ void xcd_barrier_complete(unsigned* bar, unsigned x, unsigned& nloc, unsigned& nx) {
    const unsigned G = gridDim.x * gridDim.y * gridDim.z;
    unsigned sum, cnt, mine, sp = 0u;
    for (;;) {
        sum = 0u; cnt = 0u; mine = 0u;
#pragma unroll
        for (unsigned j = 0; j < 16; ++j) { const unsigned c = xb_ld(&bar[XB_XCNT(j)]); sum += c; cnt += (c > 0u) ? 1u : 0u; mine = (j == x) ? c : mine; }
        if (sum == G) break;
        __builtin_amdgcn_s_sleep(1);
        if ((++sp & 255u) == 0u) { if (xb_ld(&bar[XB_TMO])) break; if (sp > XB_SPIN_CAP) { atomicAdd(&bar[XB_TMO], 1u); break; } }
    }
    nloc = mine > 0u ? mine : 1u; nx = cnt > 0u ? cnt : 1u;
}
__device__ __forceinline__ void xcd_barrier(const XcdBarrier& b) {
    asm volatile("s_waitcnt vmcnt(0)" ::: "memory");
    __syncthreads();
    if (threadIdx.x == 0) {
        unsigned* bar = b.bar;
        __builtin_amdgcn_s_waitcnt(0);
        unsigned nloc = b.st[0], nx = b.st[1];
        if (nloc == 0u) { xcd_barrier_complete(bar, b.x, nloc, nx); b.st[0] = nloc; b.st[1] = nx; }
        const unsigned old = xb_add(&bar[XB_XSUB(b.x)], 1u);
        const unsigned gen = old / nloc;
        if (old + 1u == (gen + 1u) * nloc) {
            __builtin_amdgcn_fence(__ATOMIC_RELEASE, "agent");
            asm volatile("s_waitcnt vmcnt(0)" ::: "memory");
            const unsigned og = xb_add(&bar[XB_TOP], 1u);
            const unsigned tg = og / nx;
            if (og + 1u == (tg + 1u) * nx) xb_add(&bar[XB_TOPGEN], 1u);
            else XB_SPIN(xb_ld(&bar[XB_TOPGEN]) == tg, bar);
            __builtin_amdgcn_fence(__ATOMIC_ACQUIRE, "agent");
            xb_add(&bar[XB_XGEN(b.x)], 1u);
            asm volatile("s_waitcnt vmcnt(0)" ::: "memory");
        } else {
            XB_SPIN(xb_ld(&bar[XB_XGEN(b.x)]) == gen, bar);
            __builtin_amdgcn_fence(__ATOMIC_ACQUIRE, "agent");
            asm volatile("s_waitcnt vmcnt(0)" ::: "memory");
        }
    }
    __syncthreads();
}

__device__ __forceinline__ void run_step(const Params& p, int step, LAS unsigned char* lds) {
    unsigned char* ws = p.ws;
    bf16_t* HB = (bf16_t*)(ws + WS_HB); float* RS = (float*)(ws + WS_RS);
    const size_t Mc = p.Mc;
    unsigned char* R1 = ws + WS_CH; unsigned char* R2 = R1 + Mc * 16896; unsigned char* R3 = R2 + Mc * 2048; float* LSE = (float*)(R3 + Mc * 5120);
    bf16_t* proj = (bf16_t*)R1; bf16_t* abuf = (bf16_t*)R1; bf16_t* edge = (bf16_t*)(R1 + Mc * 5632);
    bf16_t* zbuf = (bf16_t*)R2; bf16_t* hb2 = (bf16_t*)R2;
    bf16_t* oab = (bf16_t*)R3; bf16_t* og = (bf16_t*)(R3 + Mc * 2048); bf16_t* mix = (bf16_t*)R3;
    if (step == 0) {
        if (!PH_EN(100)) return;
        rowpass(p.x_in, HB, nullptr, nullptr, nullptr, RS, NTOK);
        convert_weights(p, 0, lds);
        return;
    }
    const int s1 = step - 1; const int ph = s1 % NPH; const int lc = s1 / NPH; const int c = lc % p.nchunk, l = lc / p.nchunk;
    const size_t row0 = (size_t)c * Mc;
    pg8::StaticOrder S;
    switch (ph) {
    case 0: if (PH_EN(0)) { pg8::Gemm g{HB + row0 * DM, (const bf16_t*)(ws + W_IN), (int)Mc, INC, DM, DM}; S.init((int)Mc, INC, gridDim.x, opaque_bid());
              pg8::EpiProj E{proj, p.pos + row0, RS + row0}; pg8::gemm_phase(lds, g, S, E); } break;
    case 1: if (PH_EN(1)) attn_phase(p, l, proj, oab, og, LSE, lds); break;
    case 2: if (PH_EN(2)) { pg8::Gemm g{oab, (const bf16_t*)(ws + W_A), (int)Mc, DM, 512, DM}; S.init((int)Mc, DM, gridDim.x, opaque_bid());
              pg8::EpiGate<0> E{zbuf, proj, 6144}; pg8::gemm_phase(lds, g, S, E); combine_phase(p, og, LSE, oab); } break;
    case 3: if (PH_EN(3)) { pg8::Gemm g{oab + 512, (const bf16_t*)(ws + W_B), (int)Mc, DM, 512, DM}; S.init((int)Mc, DM, gridDim.x, opaque_bid());
              pg8::EpiGate<1> E{zbuf, proj, 7168}; pg8::gemm_phase(lds, g, S, E); } break;
    case 4: if (PH_EN(4)) { pg8::Gemm g{zbuf, (const bf16_t*)(ws + W_MIX), (int)Mc, DM, DM, DM}; S.init((int)Mc, DM, gridDim.x, opaque_bid());
              pg8::EpiBf16 E{mix, DM}; pg8::gemm_phase(lds, g, S, E); } break;
    case 5: if (PH_EN(5)) rowpass(nullptr, HB + row0 * DM, mix, p.post_mix_g + l * DM, nullptr, RS + row0, (int)Mc); break;
    case 6: if (PH_EN(6)) { pg8::Gemm g{HB + row0 * DM, (const bf16_t*)(ws + W_UP), (int)Mc, UPC, DM, DM}; S.init((int)Mc, UPC, gridDim.x, opaque_bid());
              pg8::EpiConvGlu E{abuf, edge, p.conv_w + (size_t)l * 3 * UPC, p.conv_b + (size_t)l * UPC, RS + row0}; pg8::gemm_phase(lds, g, S, E); } break;
    case 7: if (PH_EN(7)) convfix_phase(p, l, edge, abuf); break;
    case 8: if (PH_EN(8)) { pg8::Gemm g{abuf, (const bf16_t*)(ws + W_DOWN), (int)Mc, DM, DFF, DFF}; S.init((int)Mc, DM, gridDim.x, opaque_bid());
              pg8::EpiBf16 E{mix, DM}; pg8::gemm_phase(lds, g, S, E); } break;
    case 9: if (PH_EN(9)) { rowpass(nullptr, HB + row0 * DM, mix, p.post_ffn_g + l * DM, (l + 1 < DEPTH) ? nullptr : p.out + row0 * DM, RS + row0, (int)Mc);
             if (c == p.nchunk - 1 && l + 1 < DEPTH) { convert_weights(p, l + 1, lds); if (MK_REP == 101) convert_weights(p, l + 1, lds); } }
             break;
    }
}

template <bool COOP>
__global__ void __launch_bounds__(512, 2) mk_fwd(Params p) {
    extern __shared__ __attribute__((aligned(16))) unsigned char smem[];
    LAS unsigned char* lds = (LAS unsigned char*)smem;
    XcdBarrier bar;
    if (COOP) {
        volatile LAS unsigned* st = (volatile LAS unsigned*)(lds + LDS_MAIN);
        if (threadIdx.x == 0) { st[0] = 0u; st[1] = 0u; }
        __syncthreads();
        bar = xcd_barrier_post((unsigned*)(p.ws + WS_BAR), st);
    }
    for (int step = p.ph_lo; step < p.ph_hi; ++step) {
        run_step(p, step, lds);
        if (MK_REP >= 0 && step > 0 && (step - 1) % NPH == MK_REP) { __syncthreads(); run_step(p, step, lds); }
        if (MK_REP == 100 && step == 0) { __syncthreads(); run_step(p, step, lds); }
        if (COOP && step + 1 < p.ph_hi) {
            if (step == p.ph_lo) cg::this_grid().sync();
            else xcd_barrier(bar);
        }
    }
}

extern "C" void kernel_launch(void* const* d_in, const int* in_sizes, int n_in, void* d_out, int out_size, void* d_ws, size_t ws_size, hipStream_t stream) {
    static int grid = 0; static int Mc = 0;
    if (grid == 0) {
        int dev = 0, cus = 0, per_cu = 0;
        hipGetDevice(&dev);
        hipDeviceGetAttribute(&cus, hipDeviceAttributeMultiprocessorCount, dev);
        hipFuncSetAttribute((const void*)mk_fwd<true>, hipFuncAttributeMaxDynamicSharedMemorySize, LDS_BYTES);
        hipFuncSetAttribute((const void*)mk_fwd<false>, hipFuncAttributeMaxDynamicSharedMemorySize, LDS_BYTES);
        hipOccupancyMaxActiveBlocksPerMultiprocessor(&per_cu, (const void*)mk_fwd<true>, 512, LDS_BYTES);
        if (per_cu < 1) per_cu = 1;
        grid = cus * per_cu;
        Mc = NTOK;
        while (Mc > SEQ && WS_CH + (size_t)Mc * PER_TOK > ws_size) Mc >>= 1;
        fprintf(stderr, "kernel_launch: cus %d per_cu %d grid %d Mc %d ws %zu\n", cus, per_cu, grid, Mc, ws_size);
    }
    Params p{};
    p.x_in = (const float*)d_in[0]; p.pos = (const int*)d_in[1]; p.pre_mix_g = (const float*)d_in[2]; p.w_in = (const float*)d_in[3];
    p.diff_lambda = (const float*)d_in[4]; p.diff_head_g = (const float*)d_in[5]; p.w_a_out = (const float*)d_in[6]; p.w_b_out = (const float*)d_in[7];
    p.w_mix_out = (const float*)d_in[8]; p.post_mix_g = (const float*)d_in[9]; p.pre_ffn_g = (const float*)d_in[10]; p.w_up = (const float*)d_in[11];
    p.conv_w = (const float*)d_in[12]; p.conv_b = (const float*)d_in[13]; p.w_down = (const float*)d_in[14]; p.post_ffn_g = (const float*)d_in[15];
    p.out = (float*)d_out; p.ws = (unsigned char*)d_ws; p.Mc = Mc; p.nchunk = NTOK / Mc;
    const int nsteps = 1 + DEPTH * p.nchunk * NPH;
#if MK_SINGLE
    p.ph_lo = 0; p.ph_hi = nsteps;
    if (hipMemsetAsync((char*)d_ws + WS_BAR, 0, WS_BAR_BYTES, stream) != hipSuccess) fprintf(stderr, "memset of barrier words failed\n");
    void* args[] = {&p};
    hipError_t e = hipLaunchCooperativeKernel((const void*)mk_fwd<true>, dim3(grid), dim3(512), args, LDS_BYTES, stream);
    if (e != hipSuccess) fprintf(stderr, "cooperative launch failed: %s (grid %d)\n", hipGetErrorString(e), grid);
#else
    for (int s = 0; s < nsteps; ++s) {
        p.ph_lo = s; p.ph_hi = s + 1;
        hipLaunchKernelGGL(mk_fwd<false>, dim3(grid), dim3(512), LDS_BYTES, stream, p);
    }
#endif
    (void)in_sizes; (void)n_in; (void)out_size;
}
```
